# Optimizing an MI355X kernel written in HIP

```python
import math, functools
import jax, jax.numpy as jnp
from jax import lax
import numpy as np


D_MODEL = 1024
BATCH = 16
SEQ = 2048
DEPTH = 4

GRID_W = 64
CTX_LEN = 256
MIX_W = D_MODEL
N_MIXERS = 4
BR_W = MIX_W // N_MIXERS
HEAD_DIM = 64
RET_HEADS = BR_W // HEAD_DIM
SG_HEADS = BR_W // HEAD_DIM
GDN_HEADS = BR_W // HEAD_DIM
RET_CHUNK = 128
SG_CHUNK = 128
GDN_CHUNK = 64
CONV_W = 3
ROPE_BASE = 10000.0
EPS = 1e-6
SEGMENTS = (BR_W,) * 15 + (GDN_HEADS,) * 4
IN_W = 15 * BR_W + 4 * GDN_HEADS

kernel_name = 'hybrid_parallel_mixer_dit_block'


def rms_norm(x, g):
    xf = x.astype(jnp.float32)
    y = xf * lax.rsqrt(jnp.mean(xf * xf, axis=-1, keepdims=True) + EPS)
    return (y * g.astype(jnp.float32)).astype(x.dtype)


def layer_norm_plain(x):
    xf = x.astype(jnp.float32)
    mu = jnp.mean(xf, axis=-1, keepdims=True)
    var = jnp.mean(jnp.square(xf - mu), axis=-1, keepdims=True)
    return ((xf - mu) * lax.rsqrt(var + EPS)).astype(x.dtype)


def l2_normalize(x):
    return x * lax.rsqrt(jnp.sum(x * x, axis=-1, keepdims=True) + EPS)


def dwconv_centred(x, w):
    k_w = w.shape[0]
    t = x.shape[1]
    xp = jnp.pad(x, ((0, 0), (k_w // 2, k_w // 2), (0, 0)))
    out = xp[:, 0:t] * w[0]
    for i in range(1, k_w):
        out = out + xp[:, i:i + t] * w[i]
    return out


def grid_rotary(x, row, col):
    half = x.shape[-1] // 2
    nf = half // 2
    inv = ROPE_BASE ** (-jnp.arange(nf, dtype=jnp.float32) / nf)

    def rot(xs, pos):
        ang = pos.astype(jnp.float32)[:, None] * inv
        cos, sin = jnp.cos(ang)[None, :, None, :], jnp.sin(ang)[None, :, None, :]
        x1, x2 = xs[..., :nf], xs[..., nf:]
        return jnp.concatenate([x1 * cos - x2 * sin, x1 * sin + x2 * cos], axis=-1)

    return jnp.concatenate([rot(x[..., :half], row), rot(x[..., half:], col)], axis=-1)


def split_proj(p):
    cuts = [int(i) for i in np.cumsum(SEGMENTS)[:-1]]
    return jnp.split(p, cuts, axis=-1)


def identity(a):
    return a


flip_time = functools.partial(jnp.flip, axis=1)


def retention_scan(q, k, v, log_gamma, s0, with_output):
    bsz, t, h, dk = k.shape
    n = t // RET_CHUNK

    def chunks(a):
        return a.reshape(bsz, n, RET_CHUNK, h, a.shape[-1]).transpose(1, 0, 3, 2, 4)

    pos = jnp.arange(RET_CHUNK, dtype=jnp.float32)
    lg = log_gamma[:, None]
    k_dec = jnp.exp((RET_CHUNK - 1.0 - pos) * lg)[..., None]
    c_dec = jnp.exp(RET_CHUNK * log_gamma)[:, None, None]
    kc, vc = chunks(k * dk ** -0.5), chunks(v)

    def update(s, ki, vi):
        return s * c_dec + jnp.einsum('bhcd,bhce->bhde', ki * k_dec, vi)

    if not with_output:
        s_fin, _ = lax.scan(lambda s, kv: (update(s, kv[0], kv[1]), None), s0, (kc, vc))
        return None, s_fin
    diff = pos[:, None] - pos[None, :]
    intra = jnp.exp(jnp.where(diff >= 0, diff * lg[..., None], -jnp.inf))
    q_dec = jnp.exp((pos + 1.0) * lg)[..., None]

    def step(s, inp):
        qi, ki, vi = inp
        scores = jnp.einsum('bhid,bhjd->bhij', qi, ki) * intra
        o = jnp.einsum('bhij,bhje->bhie', scores, vi) + jnp.einsum('bhid,bhde->bhie', qi, s) * q_dec
        return update(s, ki, vi), o

    s_fin, o = lax.scan(step, s0, (chunks(q), kc, vc))
    return o.transpose(1, 0, 3, 2, 4).reshape(bsz, t, h, -1), s_fin


def gated_delta_scan(q, k, v, g, beta, s0, with_output):
    bsz, t, h, dk = k.shape
    dv = v.shape[-1]
    n = t // GDN_CHUNK

    def chunks(a):
        return a.reshape(bsz, n, GDN_CHUNK, h, -1).transpose(1, 0, 3, 2, 4)

    kc, vc = chunks(k), chunks(v)
    bc = chunks(beta[..., None])
    gc = jnp.cumsum(chunks(g[..., None])[..., 0], axis=-1)
    idx = jnp.arange(GDN_CHUNK)
    diff = gc[..., :, None] - gc[..., None, :]
    decay = jnp.exp(jnp.where(idx[:, None] >= idx[None, :], diff, -jnp.inf))
    kb = kc * bc
    lower = jnp.where(idx[:, None] > idx[None, :],
                      jnp.einsum('nbhid,nbhjd->nbhij', kb, kc) * decay, 0.0)
    rhs = jnp.concatenate([vc * bc, kb * jnp.exp(gc)[..., None]], axis=-1)
    sol = lax.linalg.triangular_solve(lower, rhs, left_side=True, lower=True, unit_diagonal=True)
    uc, wc = sol[..., :dv], sol[..., dv:]
    g_last = gc[..., -1:]
    k_tail = kc * jnp.exp(g_last - gc)[..., None]
    c_dec = jnp.exp(g_last)[..., None]

    def update(s, ui, wi, kti, cdi):
        v_new = ui - jnp.einsum('bhck,bhkv->bhcv', wi, s)
        return s * cdi + jnp.einsum('bhck,bhcv->bhkv', kti, v_new), v_new

    if not with_output:
        s_fin, _ = lax.scan(lambda s, xs: (update(s, *xs)[0], None), s0, (uc, wc, k_tail, c_dec))
        return None, s_fin
    qc = chunks(q * dk ** -0.5)
    qd = qc * jnp.exp(gc)[..., None]

    def step(s, inp):
        qi, qdi, ki, di, ui, wi, kti, cdi = inp
        s_new, v_new = update(s, ui, wi, kti, cdi)
        intra = jnp.einsum('bhik,bhjk->bhij', qi, ki) * di
        o = jnp.einsum('bhck,bhkv->bhcv', qdi, s) + jnp.einsum('bhij,bhjv->bhiv', intra, v_new)
        return s_new, o

    s_fin, o = lax.scan(step, s0, (qc, qd, kc, decay, uc, wc, k_tail, c_dec))
    return o.transpose(1, 0, 3, 2, 4).reshape(bsz, t, h, dv), s_fin


def retention_mixer(lat, ctx, row, col, norm_g, ctx_out):
    def heads(a):
        return a.astype(jnp.float32).reshape(a.shape[0], a.shape[1], RET_HEADS, HEAD_DIM)

    ql, kl, vl = grid_rotary(heads(lat[0]), row, col), grid_rotary(heads(lat[1]), row, col), heads(lat[2])
    qc, kc, vc = heads(ctx[0]), heads(ctx[1]), heads(ctx[2])
    log_gamma = jnp.log(1.0 - 2.0 ** (-5.0 - jnp.arange(RET_HEADS, dtype=jnp.float32)))
    s0 = jnp.zeros((ql.shape[0], RET_HEADS, HEAD_DIM, HEAD_DIM), jnp.float32)
    o_lat, o_ctx = 0.0, 0.0
    for d in (identity, flip_time):
        oc, sc = retention_scan(d(qc), d(kc), d(vc), log_gamma, s0, ctx_out)
        ol, _ = retention_scan(d(ql), d(kl), d(vl), log_gamma, sc, True)
        o_lat = o_lat + d(ol)
        if ctx_out:
            o_ctx = o_ctx + d(oc)

    def finish(o, z):
        mu = jnp.mean(o, axis=-1, keepdims=True)
        var = jnp.mean(jnp.square(o - mu), axis=-1, keepdims=True)
        y = ((o - mu) * lax.rsqrt(var + EPS)).reshape(o.shape[0], o.shape[1], BR_W) * norm_g
        return (y * jax.nn.silu(z.astype(jnp.float32))).astype(z.dtype)

    return finish(o_lat, lat[3]), (finish(o_ctx, ctx[3]) if ctx_out else None)


def spatial_gating(u, v, z, w_s, b_s):
    bsz, t, _ = u.shape
    n = t // SG_CHUNK
    u = jax.nn.gelu(u)
    v = layer_norm_plain(jax.nn.gelu(v)).reshape(bsz, n, SG_CHUNK, SG_HEADS, HEAD_DIM)
    s = jnp.einsum('hij,bnjhd->bnihd', w_s, v) + b_s.T[:, :, None]
    return u * s.reshape(bsz, t, BR_W) * jax.nn.silu(z)


def short_conv(b, c, h, z, w):
    return b * dwconv_centred(c * h, w) * jax.nn.silu(z)


def gdn_mixer(lat, ctx, conv_w, a_log, dt_bias, norm_g, ctx_out):
    def prep(parts):
        q, k, v, _, a_f, a_b, b_f, b_b = parts
        qkv = jax.nn.silu(dwconv_centred(jnp.concatenate([q, k, v], axis=-1), conv_w)).astype(jnp.float32)
        bsz, t, _ = qkv.shape
        q, k, v = [a.reshape(bsz, t, GDN_HEADS, HEAD_DIM) for a in jnp.split(qkv, 3, axis=-1)]
        g = [-jnp.exp(a_log[i]) * jax.nn.softplus(a.astype(jnp.float32) + dt_bias[i])
             for i, a in enumerate((a_f, a_b))]
        beta = [jax.nn.sigmoid(b.astype(jnp.float32)) for b in (b_f, b_b)]
        return l2_normalize(q), l2_normalize(k), v, g, beta

    ql, kl, vl, gl, bl = prep(lat)
    qc, kc, vc, gcx, bcx = prep(ctx)
    s0 = jnp.zeros((ql.shape[0], GDN_HEADS, HEAD_DIM, HEAD_DIM), jnp.float32)
    o_lat, o_ctx = 0.0, 0.0
    for i, d in enumerate((identity, flip_time)):
        oc, sc = gated_delta_scan(d(qc), d(kc), d(vc), d(gcx[i]), d(bcx[i]), s0, ctx_out)
        ol, _ = gated_delta_scan(d(ql), d(kl), d(vl), d(gl[i]), d(bl[i]), sc, True)
        o_lat = o_lat + d(ol)
        if ctx_out:
            o_ctx = o_ctx + d(oc)

    def finish(o, z):
        y = o * lax.rsqrt(jnp.mean(o * o, axis=-1, keepdims=True) + EPS) * norm_g
        y = y.reshape(o.shape[0], o.shape[1], BR_W)
        return (y * jax.nn.silu(z.astype(jnp.float32))).astype(z.dtype)

    return finish(o_lat, lat[3]), (finish(o_ctx, ctx[3]) if ctx_out else None)


def token_mixers(p_lat, p_ctx, row, col, ret_norm_g, sg_w, sg_b, sc_conv_w,
                 gdn_conv_w, gdn_a_log, gdn_dt_bias, gdn_norm_g, ctx_out):
    lat, cx = split_proj(p_lat), split_proj(p_ctx)
    a_lat, a_ctx = retention_mixer(lat[0:4], cx[0:4], row, col, ret_norm_g, ctx_out)
    d_lat, d_ctx = gdn_mixer(lat[11:19], cx[11:19], gdn_conv_w, gdn_a_log, gdn_dt_bias, gdn_norm_g, ctx_out)
    y_lat = jnp.concatenate([a_lat, spatial_gating(*lat[4:7], sg_w, sg_b),
                             short_conv(*lat[7:11], sc_conv_w), d_lat], axis=-1).astype(p_lat.dtype)
    if not ctx_out:
        return y_lat, None
    y_ctx = jnp.concatenate([a_ctx, spatial_gating(*cx[4:7], sg_w, sg_b),
                             short_conv(*cx[7:11], sc_conv_w), d_ctx], axis=-1).astype(p_ctx.dtype)
    return y_lat, y_ctx


def setup_inputs(seed: int = 0) -> dict:
    key = jax.random.key(seed)
    ks = jax.random.split(key, 18)

    def nrm(k, shape, s):
        return jax.random.normal(k, shape, jnp.float32) * s

    dt = jnp.exp(jax.random.uniform(ks[16], (DEPTH, 2, GDN_HEADS), jnp.float32,
                                    minval=math.log(1e-3), maxval=math.log(1e-1)))
    return {
        'x': nrm(ks[0], (BATCH, SEQ, D_MODEL), 1.0),
        'c': nrm(ks[1], (BATCH, D_MODEL), 1.0),
        'ctx': nrm(ks[2], (BATCH, CTX_LEN, D_MODEL), 1.0),
        'c_ctx': nrm(ks[3], (D_MODEL,), 1.0),
        'w_mod': nrm(ks[4], (DEPTH, D_MODEL, 3 * D_MODEL), 0.5 * D_MODEL ** -0.5),
        'b_mod': nrm(ks[5], (DEPTH, 3 * D_MODEL), 0.02),
        'g_pre': 1.0 + nrm(ks[6], (DEPTH, D_MODEL), 0.02),
        'g_post': 1.0 + nrm(ks[7], (DEPTH, D_MODEL), 0.02),
        'w_in': nrm(ks[8], (DEPTH, D_MODEL, IN_W), D_MODEL ** -0.5),
        'w_out': nrm(ks[9], (DEPTH, MIX_W, D_MODEL), MIX_W ** -0.5),
        'ret_norm_g': 1.0 + nrm(ks[10], (DEPTH, BR_W), 0.02),
        'sg_w': nrm(ks[11], (DEPTH, SG_HEADS, SG_CHUNK, SG_CHUNK), SG_CHUNK ** -0.5),
        'sg_b': 1.0 + nrm(ks[12], (DEPTH, SG_HEADS, SG_CHUNK), 0.1),
        'sc_conv_w': nrm(ks[13], (DEPTH, CONV_W, BR_W), CONV_W ** -0.5),
        'gdn_conv_w': nrm(ks[14], (DEPTH, CONV_W, 3 * BR_W), CONV_W ** -0.5),
        'gdn_a_log': jnp.log(jax.random.uniform(ks[15], (DEPTH, 2, GDN_HEADS), jnp.float32, minval=1.0, maxval=16.0)),
        'gdn_dt_bias': dt + jnp.log(-jnp.expm1(-dt)),
        'gdn_norm_g': 1.0 + nrm(ks[17], (DEPTH, HEAD_DIM), 0.02),
    }


def reference(x, c, ctx, c_ctx, w_mod, b_mod, g_pre, g_post, w_in, w_out, ret_norm_g, sg_w, sg_b,
              sc_conv_w, gdn_conv_w, gdn_a_log, gdn_dt_bias, gdn_norm_g):
    rows = x.shape[1] // GRID_W
    row = jnp.repeat(jnp.arange(rows), GRID_W)
    col = jnp.tile(jnp.arange(GRID_W), rows)
    silu_c = jax.nn.silu(c)
    silu_cc = jax.nn.silu(c_ctx)
    for l in range(DEPTH):
        ctx_out = l < DEPTH - 1
        shift, scale, gate = jnp.split(silu_c @ w_mod[l] + b_mod[l], 3, axis=-1)
        shift_c, scale_c, gate_c = jnp.split(silu_cc @ w_mod[l] + b_mod[l], 3, axis=-1)
        h = rms_norm(x, g_pre[l]) * (1.0 + scale[:, None]) + shift[:, None]
        hc = rms_norm(ctx, g_pre[l]) * (1.0 + scale_c) + shift_c
        y, yc = token_mixers(h @ w_in[l], hc @ w_in[l], row, col, ret_norm_g[l], sg_w[l], sg_b[l],
                             sc_conv_w[l], gdn_conv_w[l], gdn_a_log[l], gdn_dt_bias[l], gdn_norm_g[l], ctx_out)
        x = x + gate[:, None] * rms_norm(y @ w_out[l], g_post[l])
        if ctx_out:
            ctx = ctx + gate_c * rms_norm(yc @ w_out[l], g_post[l])
    return x
```

```cpp
#include <hip/hip_runtime.h>
#include <hip/hip_cooperative_groups.h>
#include <cstdint>
#include <cstdio>
namespace cg = cooperative_groups;

#ifndef MK_MULTI
#define MK_MULTI 0
#endif

#define LAS __attribute__((address_space(3)))
__device__ __forceinline__ int TIDX() { int t = threadIdx.x; asm volatile("" : "+v"(t)); return t; }
typedef unsigned short bf16_t;
typedef short bf16x8 __attribute__((ext_vector_type(8)));
typedef float f32x4 __attribute__((ext_vector_type(4)));
typedef float f32x2 __attribute__((ext_vector_type(2)));
typedef unsigned u32x4 __attribute__((ext_vector_type(4)));
typedef unsigned u32x2 __attribute__((ext_vector_type(2)));

constexpr int DM = 1024, NB = 16, TL = 2048, TC = 256, DEPTH = 4;
constexpr int RL = NB * TL, RC = NB * TC, RT = RL + RC;
constexpr int PW = 3840, INW = 3856;
constexpr float EPS = 1e-6f;
constexpr unsigned long long POSPACK = 0xCEDBA9786543210ull;
constexpr int C_RQ = 0, C_RK = 256, C_RV = 512, C_RZ = 768, C_SU = 1024, C_SV = 1280, C_SZ = 1536, C_CC = 1792, C_CB = 2048, C_CH = 2304, C_CZ = 2560,
              C_GQ = 2816, C_GZ = 3072, C_GK = 3328, C_GV = 3584;

constexpr size_t MiB = 1u << 20;
constexpr size_t WS_CTL = 0;
constexpr size_t WS_ROPE = 512 * 1024;
constexpr size_t WS_MOD = 1 * MiB;
constexpr size_t WS_WEXT = 2 * MiB;
constexpr size_t WS_WIN = 3 * MiB;
constexpr size_t WS_WOUT = 33 * MiB;
constexpr size_t WS_XC = 41 * MiB;
constexpr size_t WS_EXT = 57 * MiB;
constexpr size_t WS_KV = 60 * MiB;
constexpr size_t WS_X = 78 * MiB;
constexpr size_t WS_O = WS_X, WS_H = WS_X + 72 * MiB;
constexpr size_t WS_P = 222 * MiB;
constexpr size_t WS_GB = 492 * MiB;
constexpr size_t WS_END = 495 * MiB;
constexpr size_t WS_OG = WS_X;
constexpr size_t WS_GQ = WS_X + 72 * MiB, WS_GK = WS_GQ + 18 * MiB, WS_GV = WS_GK + 18 * MiB;
constexpr size_t WS_SGV = WS_X + 72 * MiB;

constexpr int LDS_BYTES = 147456;

struct Args {
    const float *x, *c, *ctx, *c_ctx, *w_mod, *b_mod, *g_pre, *g_post, *w_in, *w_out, *ret_norm_g, *sg_w, *sg_b, *sc_conv_w, *gdn_conv_w, *gdn_a_log, *gdn_dt_bias, *gdn_norm_g;
    float* out; unsigned char* ws; int st_lo, st_hi, coop, pad;
};

typedef const __attribute__((address_space(4))) Args* KA;

__device__ __forceinline__ float bf2f(unsigned v) { return __uint_as_float(v << 16); }
__device__ __forceinline__ unsigned cvt_pk_bf16(float lo, float hi) { unsigned r; asm volatile("v_cvt_pk_bf16_f32 %0, %1, %2" : "=v"(r) : "v"(lo), "v"(hi)); return r; }
__device__ __forceinline__ unsigned f2bf(float f) { return cvt_pk_bf16(f, 0.f) & 0xffffu; }
__device__ __forceinline__ float wave_sum(float v) {
#pragma unroll
    for (int o = 1; o < 64; o <<= 1) v += __shfl_xor(v, o);
    return v;
}
__device__ __forceinline__ float silu_f(float x) { return x / (1.f + __expf(-x)); }
__device__ __forceinline__ float gelu_f(float x) { const float u = 0.7978845608028654f * (x + 0.044715f * x * x * x); return 0.5f * x * (1.f + tanhf(u)); }
__device__ __forceinline__ float softplus_f(float x) { return x > 20.f ? x : log1pf(__expf(x)); }
__device__ __forceinline__ float sigmoid_f(float x) { return 1.f / (1.f + __expf(-x)); }

namespace pg8 {
constexpr int BM = 256, BK = 64, HALF = 128, HTB = HALF * BK * 2, STAGE_BYTES = 8 * HTB, NXCD = 8, WGM = 8;
__host__ __device__ __forceinline__ int lds_byte(int r, int c) { const int st = (r >> 4) * 2 + (c >> 5), rr = r & 15, cc = c & 31, ob = rr * 64 + cc * 2; return st * 1024 + (ob ^ (((ob >> 9) & 1) << 5)); }
__host__ __device__ __forceinline__ void stage_rc(int b, int& R, int& C) { const int st = b / 1024, sb = b % 1024, swz = sb ^ (((sb >> 9) & 1) << 5); R = (st >> 1) * 16 + swz / 64; C = (st & 1) * 32 + (swz % 64) / 2; }
__host__ __device__ __forceinline__ int perm32(int rho) { const int n = rho >> 4, i = rho & 15; return 8 * (i >> 2) + 4 * n + (i & 3); }
struct Unit { int pm, pn; };
struct Gemm { const bf16_t* A; const bf16_t* Bt; int M, N, K, lda, seg; };
struct StaticOrder {
    int nM, nN, nwg, G, c;
    __host__ __device__ void init(int M, int N, int G_, int c_) { nM = M / BM; nN = N / BM; nwg = nM * nN; G = G_; c = c_; }
    __host__ __device__ bool next(int i, Unit& u) const {
        const long L = (long)i * G + c; if (L >= nwg) return false;
        int wgid = (int)L; { const int q = nwg / NXCD, r = nwg % NXCD, xcd = wgid % NXCD, off = wgid / NXCD; wgid = (xcd < r ? xcd * (q + 1) : r * (q + 1) + (xcd - r) * q) + off; }
        const int nig = WGM * nN, gid = wgid / nig, fm = gid * WGM, gsz = (nM - fm) < WGM ? (nM - fm) : WGM;
        u.pm = fm + ((wgid % nig) % gsz); u.pn = (wgid % nig) / gsz; return true;
    }
};
struct EpiBf16 {
    bf16_t* O; int ldc;
    __device__ __forceinline__ void operator()(const f32x4 (&acc)[2][2][4][2], const Unit& u, int wr, int wc, int fr, int fq) const {
        const int row0 = u.pm * BM + wr * 64 + fr, col0 = u.pn * BM + wc * 32 + 8 * fq;
#pragma unroll
        for (int ai = 0; ai < 2; ++ai)
#pragma unroll
            for (int m = 0; m < 4; ++m) { bf16_t* rowp = O + (size_t)(row0 + ai * HALF + m * 16) * ldc + col0;
#pragma unroll
                for (int bj = 0; bj < 2; ++bj) { const f32x4 v0 = acc[ai][bj][m][0], v1 = acc[ai][bj][m][1];
                    u32x4 w; w.x = cvt_pk_bf16(v0[0], v0[1]); w.y = cvt_pk_bf16(v0[2], v0[3]); w.z = cvt_pk_bf16(v1[0], v1[1]); w.w = cvt_pk_bf16(v1[2], v1[3]);
                    *(u32x4*)(rowp + bj * HALF) = w; } }
    }
};

template <class Epi>
__device__ __forceinline__ void gemm_phase(LAS unsigned char* lds, const Gemm g, const StaticOrder& S, const Epi& E) {
    const int tid = TIDX(), wid = __builtin_amdgcn_readfirstlane(tid >> 6), lane = tid & 63, wr = wid >> 2, wc = wid & 3, fr = lane & 15, fq = lane >> 4;
    const int K = g.K, nt = K / BK, lda = g.lda, seg = g.seg;
    unsigned voffA[2], voffB[2];
#pragma unroll
    for (int i = 0; i < 2; ++i) { int R, C; stage_rc(tid * 16 + i * 8192, R, C); const int Rb = (R & ~31) + perm32(R & 31);
        voffA[i] = (unsigned)(R * lda + C) * 2u; voffB[i] = (unsigned)(Rb * K + C) * 2u; }
    const size_t kstep = (size_t)(BK * 2);
    const size_t hstepA = (size_t)HALF * lda * 2, hstepB = (size_t)HALF * K * 2;
    const size_t tstepA = 2 * hstepA, tstepB = 2 * hstepB;
#define KOFFA(t) (seg ? ((size_t)((t) >> 2) * 2048 + (size_t)((t) & 3) * 128) : (size_t)(t) * 128)
    const unsigned ldsw = (unsigned)wid * 1024u;
    const int aoff = lds_byte(wr * 64 + fr, fq * 8), boff = lds_byte(wc * 32 + fr, fq * 8);
#define PG8_SA(b, h) (((b) * 2 + (h)) * HTB)
#define PG8_SB(b, h) ((4 + (b) * 2 + (h)) * HTB)
#define PG8_STAGE(bufoff, gbase, voff) do { _Pragma("unroll") for (int _i = 0; _i < 2; ++_i) \
        __builtin_amdgcn_global_load_lds((const unsigned*)((const char*)(gbase) + (voff)[_i]), (LAS unsigned*)(lds + (bufoff) + ldsw + _i * 8192), 16, 0, 0); } while (0)
#define PG8_LDA(dst, b, h) do { _Pragma("unroll") for (int m = 0; m < 4; ++m) _Pragma("unroll") for (int k = 0; k < 2; ++k) dst[m][k] = *(const LAS bf16x8*)(lds + PG8_SA(b, h) + aoff + m * 2048 + k * 1024); } while (0)
#define PG8_LDB(dst, b, h) do { _Pragma("unroll") for (int n = 0; n < 2; ++n) _Pragma("unroll") for (int k = 0; k < 2; ++k) dst[n][k] = *(const LAS bf16x8*)(lds + PG8_SB(b, h) + boff + n * 2048 + k * 1024); } while (0)
#define PG8_MMA(ai, bj, At, Bt) do { __builtin_amdgcn_s_setprio(1); _Pragma("unroll") for (int m = 0; m < 4; ++m) _Pragma("unroll") for (int n = 0; n < 2; ++n) _Pragma("unroll") for (int k = 0; k < 2; ++k) \
        acc[ai][bj][m][n] = __builtin_amdgcn_mfma_f32_16x16x32_bf16(Bt[n][k], At[m][k], acc[ai][bj][m][n], 0, 0, 0); __builtin_amdgcn_s_setprio(0); } while (0)
#define PG8_WAIT_V(n) asm volatile("s_waitcnt vmcnt(" #n ")" ::: "memory")
#define PG8_WAIT_L(n) asm volatile("s_waitcnt lgkmcnt(" #n ")" ::: "memory")
#define PG8_BAR __builtin_amdgcn_s_barrier()
#define PG8_SCHED __builtin_amdgcn_sched_barrier(0)
    Unit cur, nxt; int ui = 0;
    if (!S.next(0, cur)) return;
    f32x4 acc[2][2][4][2];
#pragma unroll
    for (int a = 0; a < 2; ++a)
#pragma unroll
        for (int b = 0; b < 2; ++b)
#pragma unroll
            for (int m = 0; m < 4; ++m)
#pragma unroll
                for (int n = 0; n < 2; ++n) acc[a][b][m][n] = (f32x4){0.f, 0.f, 0.f, 0.f};
    bf16x8 At[4][2], B0[2][2], B1[2][2];
    const char* cA = (const char*)g.A + (size_t)cur.pm * tstepA; const char* cB = (const char*)g.Bt + (size_t)cur.pn * tstepB;
    PG8_STAGE(PG8_SB(0, 0), cB, voffB); PG8_STAGE(PG8_SB(0, 1), cB + hstepB, voffB); PG8_STAGE(PG8_SA(0, 0), cA, voffA); PG8_STAGE(PG8_SA(0, 1), cA + hstepA, voffA);
    if (wr == 1) PG8_BAR;
    PG8_WAIT_V(2); PG8_BAR;
    PG8_STAGE(PG8_SB(1, 0), cB + kstep, voffB); PG8_STAGE(PG8_SA(1, 0), cA + KOFFA(1), voffA); PG8_STAGE(PG8_SB(1, 1), cB + hstepB + kstep, voffB);
    PG8_WAIT_V(6); PG8_BAR;
    for (;;) {
        const bool has_next = S.next(ui + 1, nxt);
        const char* nA = has_next ? (const char*)g.A + (size_t)nxt.pm * tstepA : cA; const char* nB = has_next ? (const char*)g.Bt + (size_t)nxt.pn * tstepB : cB;
        for (int t = 0; t < nt; t += 2) {
            const bool last = (t == nt - 2);
            const char* a1 = cA + KOFFA(t + 1);
            const char* a2 = last ? nA : cA + KOFFA(t + 2); const char* b2 = last ? nB : cB + (size_t)(t + 2) * kstep;
            const char* a3 = last ? nA + KOFFA(1) : cA + KOFFA(t + 3); const char* b3 = b2 + kstep;
            PG8_LDB(B0, 0, 0); PG8_LDB(B1, 0, 1); PG8_SCHED; PG8_LDA(At, 0, 0); PG8_STAGE(PG8_SA(1, 1), a1 + hstepA, voffA);
            PG8_WAIT_V(8); PG8_WAIT_L(0); PG8_BAR; PG8_MMA(0, 0, At, B0); PG8_MMA(0, 1, At, B1); PG8_BAR; PG8_SCHED;
            PG8_LDA(At, 0, 1); PG8_STAGE(PG8_SB(0, 0), b2, voffB); PG8_STAGE(PG8_SB(0, 1), b2 + hstepB, voffB); PG8_STAGE(PG8_SA(0, 0), a2, voffA);
            PG8_WAIT_V(8); PG8_WAIT_L(0); PG8_BAR; PG8_MMA(1, 0, At, B0); PG8_MMA(1, 1, At, B1); PG8_BAR; PG8_SCHED;
            PG8_LDB(B0, 1, 0); PG8_LDB(B1, 1, 1); PG8_SCHED; PG8_LDA(At, 1, 0); PG8_STAGE(PG8_SA(0, 1), a2 + hstepA, voffA);
            PG8_WAIT_V(8); PG8_WAIT_L(0); PG8_BAR; PG8_MMA(0, 0, At, B0); PG8_MMA(0, 1, At, B1); PG8_BAR; PG8_SCHED;
            PG8_LDA(At, 1, 1); PG8_STAGE(PG8_SB(1, 0), b3, voffB); PG8_STAGE(PG8_SB(1, 1), b3 + hstepB, voffB); PG8_STAGE(PG8_SA(1, 0), a3, voffA);
            PG8_WAIT_V(8); PG8_WAIT_L(0); PG8_BAR; PG8_MMA(1, 0, At, B0); PG8_MMA(1, 1, At, B1); PG8_BAR; PG8_SCHED;
        }
        if (wr == 0) PG8_BAR;
        E(acc, cur, wr, wc, fr, fq);
        if (!has_next) break;
#pragma unroll
        for (int a = 0; a < 2; ++a)
#pragma unroll
            for (int b = 0; b < 2; ++b)
#pragma unroll
                for (int m = 0; m < 4; ++m)
#pragma unroll
                    for (int n = 0; n < 2; ++n) acc[a][b][m][n] = (f32x4){0.f, 0.f, 0.f, 0.f};
        cur = nxt; cA = nA; cB = nB; ++ui;
        if (wr == 1) PG8_BAR;
    }
    PG8_WAIT_V(0);
    PG8_BAR;
#undef KOFFA
#undef PG8_SA
#undef PG8_SB
#undef PG8_STAGE
#undef PG8_LDA
#undef PG8_LDB
#undef PG8_MMA
#undef PG8_WAIT_V
#undef PG8_WAIT_L
#undef PG8_BAR
#undef PG8_SCHED
}
}

__device__ __forceinline__ int seq_row(int b, int s) { return s < TC ? RL + b * TC + s : b * TL + (s - TC); }

__device__ __forceinline__ void transpose_item(const float* W, int N, int item, int nblk, bf16_t* dst_main, bf16_t* dst_ext, bool is_in, LAS float* scr, int lane) {
    const int kb = item / nblk, nb = item % nblk, k0 = 64 * kb, n0 = 32 * nb;
    { const int n = n0 + (lane & 31);
#pragma unroll 8
      for (int i = 0; i < 32; ++i) { const int kk = 2 * i + (lane >> 5); scr[kk * 33 + (lane & 31)] = n < N ? W[(size_t)(k0 + kk) * N + n] : 0.f; } }
    asm volatile("s_waitcnt lgkmcnt(0)" ::: "memory");
    const int c = lane & 7;
#pragma unroll
    for (int j = 0; j < 4; ++j) { const int nl = (lane >> 3) + 8 * j, n = n0 + nl; const LAS float* s = scr + (8 * c) * 33 + nl;
        u32x4 o; o.x = cvt_pk_bf16(s[0 * 33], s[1 * 33]); o.y = cvt_pk_bf16(s[2 * 33], s[3 * 33]); o.z = cvt_pk_bf16(s[4 * 33], s[5 * 33]); o.w = cvt_pk_bf16(s[6 * 33], s[7 * 33]);
        if (n < N) { bf16_t* rowp;
            if (is_in) { if (n < PW) { const int sg = n >> 8, pos = (int)((POSPACK >> (4 * sg)) & 15ull); rowp = dst_main + (size_t)(pos * 256 + (n & 255)) * DM; } else rowp = dst_ext + (size_t)(n - PW) * DM; }
            else rowp = dst_main + (size_t)n * DM;
            *(u32x4*)(rowp + k0 + 8 * c) = o; } }
    asm volatile("s_waitcnt lgkmcnt(0)" ::: "memory");
}

__device__ __forceinline__ void phase_prologue(KA a, LAS unsigned char* lds, int bid, int G) {
    const int tid = TIDX(), wave = tid >> 6, lane = tid & 63;
    unsigned char* ws = a->ws;
    if (bid == G - 1) { float* rope = (float*)(ws + WS_ROPE);
        for (int i = tid; i < 1024; i += 512) { const int pos = i >> 4, f = i & 15; const float inv = expf(-9.210340371976184f * (float)f * (1.f / 16.f)); const float ang = (float)pos * inv;
            rope[i] = cosf(ang); rope[1024 + i] = sinf(ang); } }
    for (int it = bid; it < 96; it += G) {
        LAS float* s = (LAS float*)lds;
        for (int i = tid; i < 17 * 1024; i += 512) { const int r = i >> 10, k = i & 1023; const float v = r < 16 ? a->c[r * 1024 + k] : a->c_ctx[k]; s[i] = silu_f(v); }
        __syncthreads();
        const int l = it / 24, j0 = (it % 24) * 128;
        f32x2 acc[17];
#pragma unroll
        for (int r = 0; r < 17; ++r) acc[r] = (f32x2){0.f, 0.f};
        const float* wp = a->w_mod + ((size_t)l * 1024 + wave * 128) * 3072 + j0 + lane * 2;
#pragma unroll 4
        for (int k = 0; k < 128; ++k) { const f32x2 w2 = *(const f32x2*)(wp + (size_t)k * 3072);
#pragma unroll
            for (int r = 0; r < 17; ++r) { const float sv = s[r * 1024 + wave * 128 + k]; acc[r] += sv * w2; } }
        __syncthreads();
        LAS float* part = (LAS float*)lds;
#pragma unroll
        for (int r = 0; r < 17; ++r) *(LAS f32x2*)(part + (wave * 17 + r) * 128 + lane * 2) = acc[r];
        __syncthreads();
        float* mod = (float*)(ws + WS_MOD);
        for (int i = tid; i < 17 * 128; i += 512) { const int r = i >> 7, cc = i & 127; float v = a->b_mod[l * 3072 + j0 + cc];
#pragma unroll
            for (int w = 0; w < 8; ++w) v += part[(w * 17 + r) * 128 + cc];
            mod[((size_t)l * 17 + r) * 3072 + j0 + cc] = v; }
        __syncthreads();
    }
    __syncthreads();
    LAS float* scr = (LAS float*)lds + wave * (64 * 33);
    const int gw = bid * 8 + wave, NGW = G * 8;
    constexpr int I_IN = 16 * 121, I_OUT = 16 * 32, NIT = DEPTH * (I_IN + I_OUT);
    for (int it = gw; it < NIT; it += NGW) {
        const int l = it / (I_IN + I_OUT), r = it % (I_IN + I_OUT);
        if (r < I_IN) transpose_item(a->w_in + (size_t)l * DM * INW, INW, r, 121, (bf16_t*)(ws + WS_WIN) + (size_t)l * PW * DM, (bf16_t*)(ws + WS_WEXT) + (size_t)l * 16 * DM, true, scr, lane);
        else transpose_item(a->w_out + (size_t)l * DM * DM, DM, r - I_IN, 32, (bf16_t*)(ws + WS_WOUT) + (size_t)l * DM * DM, nullptr, false, scr, lane);
    }
}

__device__ __forceinline__ void phase_norm(KA a, int l, int bid, int G) {
    const int tid = TIDX(), wave = tid >> 6, lane = tid & 63;
    unsigned char* ws = a->ws;
    const float* mod = (const float*)(ws + WS_MOD);
    const bf16_t* O = (const bf16_t*)(ws + WS_O); bf16_t* H = (bf16_t*)(ws + WS_H); float* XC = (float*)(ws + WS_XC);
    const int nrows = (l == DEPTH) ? RL : RT;
    for (int r = bid * 8 + wave; r < nrows; r += G * 8) {
        const bool is_ctx = r >= RL; const int mr = is_ctx ? 16 : (r >> 11);
        const float* xp = (l <= 1) ? (is_ctx ? a->ctx + (size_t)(r - RL) * DM : a->x + (size_t)r * DM) : (is_ctx ? XC + (size_t)(r - RL) * DM : a->out + (size_t)r * DM);
        f32x4 v[4];
#pragma unroll
        for (int j = 0; j < 4; ++j) v[j] = *(const f32x4*)(xp + 4 * lane + 256 * j);
        if (l > 0) {
            f32x4 o[4]; float ss = 0.f;
#pragma unroll
            for (int j = 0; j < 4; ++j) { const u32x2 w = *(const u32x2*)(O + (size_t)r * DM + 4 * lane + 256 * j);
                o[j] = (f32x4){bf2f(w.x & 0xffffu), bf2f(w.x >> 16), bf2f(w.y & 0xffffu), bf2f(w.y >> 16)};
                ss += o[j][0] * o[j][0] + o[j][1] * o[j][1] + o[j][2] * o[j][2] + o[j][3] * o[j][3]; }
            const float rs = rsqrtf(wave_sum(ss) * (1.f / DM) + EPS);
            const float* gate = mod + ((size_t)(l - 1) * 17 + mr) * 3072 + 2048; const float* gp = a->g_post + (size_t)(l - 1) * DM;
            float* xo = is_ctx ? XC + (size_t)(r - RL) * DM : a->out + (size_t)r * DM;
#pragma unroll
            for (int j = 0; j < 4; ++j) { const int col = 4 * lane + 256 * j; const f32x4 gt = *(const f32x4*)(gate + col), g4 = *(const f32x4*)(gp + col);
                v[j] += gt * (o[j] * rs * g4); *(f32x4*)(xo + col) = v[j]; }
        }
        if (l < DEPTH) {
            float ss = 0.f;
#pragma unroll
            for (int j = 0; j < 4; ++j) ss += v[j][0] * v[j][0] + v[j][1] * v[j][1] + v[j][2] * v[j][2] + v[j][3] * v[j][3];
            const float rs = rsqrtf(wave_sum(ss) * (1.f / DM) + EPS);
            const float* mrow = mod + ((size_t)l * 17 + mr) * 3072; const float* gpre = a->g_pre + (size_t)l * DM;
#pragma unroll
            for (int j = 0; j < 4; ++j) { const int col = 4 * lane + 256 * j; const f32x4 sh = *(const f32x4*)(mrow + col), sc = *(const f32x4*)(mrow + 1024 + col), g4 = *(const f32x4*)(gpre + col);
                const f32x4 h = v[j] * rs * g4 * (sc + 1.f) + sh; u32x2 w; w.x = cvt_pk_bf16(h[0], h[1]); w.y = cvt_pk_bf16(h[2], h[3]);
                *(u32x2*)(H + (size_t)r * DM + col) = w; }
        }
    }
}

__device__ __forceinline__ void ext_unit(KA a, int l, int u) {
    const int tid = TIDX(), wave = tid >> 6, lane = tid & 63, fr = lane & 15, fq = lane >> 4;
    const bf16_t* H = (const bf16_t*)(a->ws + WS_H); const bf16_t* We = (const bf16_t*)(a->ws + WS_WEXT) + (size_t)l * 16 * DM; float* EXT = (float*)(a->ws + WS_EXT);
    const int row0 = u * 256 + wave * 32;
    f32x4 acc[2] = {(f32x4){0.f, 0.f, 0.f, 0.f}, (f32x4){0.f, 0.f, 0.f, 0.f}};
    const bf16_t* ap0 = H + (size_t)(row0 + fr) * DM + fq * 8; const bf16_t* ap1 = ap0 + 16 * DM; const bf16_t* bp = We + (size_t)fr * DM + fq * 8;
#pragma unroll 8
    for (int ks = 0; ks < 32; ++ks) { const bf16x8 b = *(const bf16x8*)(bp + ks * 32), a0 = *(const bf16x8*)(ap0 + ks * 32), a1 = *(const bf16x8*)(ap1 + ks * 32);
        acc[0] = __builtin_amdgcn_mfma_f32_16x16x32_bf16(a0, b, acc[0], 0, 0, 0); acc[1] = __builtin_amdgcn_mfma_f32_16x16x32_bf16(a1, b, acc[1], 0, 0, 0); }
#pragma unroll
    for (int mt = 0; mt < 2; ++mt)
#pragma unroll
        for (int r = 0; r < 4; ++r) EXT[(size_t)(row0 + 16 * mt + fq * 4 + r) * 16 + fr] = acc[mt][r];
}
__device__ __forceinline__ void phase_gemm(KA a, int l, bool is_out, LAS unsigned char* lds, int bid, int G) {
    const int M = (is_out && l == DEPTH - 1) ? RL : RT, N = is_out ? DM : PW;
    pg8::Gemm g;
    g.A = is_out ? (const bf16_t*)(a->ws + WS_P) : (const bf16_t*)(a->ws + WS_H);
    g.Bt = is_out ? (const bf16_t*)(a->ws + WS_WOUT) + (size_t)l * DM * DM : (const bf16_t*)(a->ws + WS_WIN) + (size_t)l * PW * DM;
    g.M = M; g.N = N; g.K = DM; g.lda = is_out ? PW : DM; g.seg = is_out ? 1 : 0;
    pg8::StaticOrder S; S.init(M, N, G, bid);
    pg8::EpiBf16 E{is_out ? (bf16_t*)(a->ws + WS_O) : (bf16_t*)(a->ws + WS_P), N};
    pg8::gemm_phase<pg8::EpiBf16>(lds, g, S, E);
    if (!is_out) { const int nwg = (RT / 256) * (PW / 256), first = nwg % G;
        for (int u = (bid - first + G) % G; u < RT / 256; u += G) ext_unit(a, l, u); }
}

__device__ __forceinline__ void phase_sc(KA a, int l, int bid, int G) {
    bf16_t* P = (bf16_t*)(a->ws + WS_P); const float* cw = a->sc_conv_w + (size_t)l * 3 * 256;
    const int nrows = (l == DEPTH - 1) ? RL : RT;
    for (int it = bid * 512 + TIDX(); it < nrows * 32; it += G * 512) {
        const int r = it >> 5, c8 = (it & 31) * 8; const bool is_ctx = r >= RL; const int t = is_ctx ? ((r - RL) & 255) : (r & 2047), len = is_ctx ? TC : TL;
        bf16_t* row = P + (size_t)r * PW;
        float ch[3][8];
#pragma unroll
        for (int d = 0; d < 3; ++d) { const int tt = t + d - 1; const bool ok = tt >= 0 && tt < len;
            u32x4 cv = (u32x4){0, 0, 0, 0}, hv = (u32x4){0, 0, 0, 0};
            if (ok) { cv = *(const u32x4*)(row + (ptrdiff_t)(d - 1) * PW + C_CC + c8); hv = *(const u32x4*)(row + (ptrdiff_t)(d - 1) * PW + C_CH + c8); }
#pragma unroll
            for (int e = 0; e < 4; ++e) { ch[d][2 * e] = bf2f(cv[e] & 0xffffu) * bf2f(hv[e] & 0xffffu); ch[d][2 * e + 1] = bf2f(cv[e] >> 16) * bf2f(hv[e] >> 16); } }
        const u32x4 bv = *(const u32x4*)(row + C_CB + c8), zv = *(const u32x4*)(row + C_CZ + c8);
        float y[8];
#pragma unroll
        for (int e = 0; e < 8; ++e) { const float conv = cw[c8 + e] * ch[0][e] + cw[256 + c8 + e] * ch[1][e] + cw[512 + c8 + e] * ch[2][e];
            const float bb = bf2f((e & 1) ? (bv[e >> 1] >> 16) : (bv[e >> 1] & 0xffffu)), zz = bf2f((e & 1) ? (zv[e >> 1] >> 16) : (zv[e >> 1] & 0xffffu));
            y[e] = bb * conv * silu_f(zz); }
        u32x4 o; o.x = cvt_pk_bf16(y[0], y[1]); o.y = cvt_pk_bf16(y[2], y[3]); o.z = cvt_pk_bf16(y[4], y[5]); o.w = cvt_pk_bf16(y[6], y[7]);
        *(u32x4*)(row + C_CB + c8) = o;
    }
}
__device__ __forceinline__ void phase_sg1(KA a, int l, int bid, int G) {
    const int wave = TIDX() >> 6, lane = TIDX() & 63;
    const bf16_t* P = (const bf16_t*)(a->ws + WS_P); float* SGV = (float*)(a->ws + WS_SGV);
    const int nrows = (l == DEPTH - 1) ? RL : RT;
    for (int r = bid * 8 + wave; r < nrows; r += G * 8) {
        const u32x2 w = *(const u32x2*)(P + (size_t)r * PW + C_SV + 4 * lane);
        f32x4 v = (f32x4){gelu_f(bf2f(w.x & 0xffffu)), gelu_f(bf2f(w.x >> 16)), gelu_f(bf2f(w.y & 0xffffu)), gelu_f(bf2f(w.y >> 16))};
        const float mu = wave_sum(v[0] + v[1] + v[2] + v[3]) * (1.f / 256.f); v = v - mu;
        const float var = wave_sum(v[0] * v[0] + v[1] * v[1] + v[2] * v[2] + v[3] * v[3]) * (1.f / 256.f);
        *(f32x4*)(SGV + (size_t)r * 256 + 4 * lane) = v * rsqrtf(var + EPS);
    }
}
__device__ __forceinline__ void phase_sg2(KA a, int l, LAS unsigned char* lds, int bid, int G) {
    const int tid = TIDX(); bf16_t* P = (bf16_t*)(a->ws + WS_P); const float* SGV = (const float*)(a->ws + WS_SGV);
    LAS float* sv = (LAS float*)lds;
    const int nch = (l == DEPTH - 1) ? 16 : 18;
    for (int it = bid; it < NB * nch; it += G) {
        const int b = it / nch, c = it % nch, base = c < 16 ? b * TL + c * 128 : RL + b * TC + (c - 16) * 128;
        __syncthreads();
        for (int i = tid; i < 128 * 64; i += 512) *(LAS f32x4*)(sv + i * 4) = *(const f32x4*)(SGV + (size_t)base * 256 + i * 4);
        __syncthreads();
        const int ch = tid & 255, h = ch >> 6, i0 = (tid >> 8) * 64;
        const float* W = a->sg_w + ((size_t)l * 4 + h) * 128 * 128; const float* bs = a->sg_b + ((size_t)l * 4 + h) * 128;
        for (int i = i0; i < i0 + 64; ++i) {
            float s = bs[i]; const float* wr = W + (size_t)i * 128;
#pragma unroll 16
            for (int j = 0; j < 128; ++j) s += wr[j] * sv[j * 256 + ch];
            bf16_t* row = P + (size_t)(base + i) * PW;
            const float u = bf2f(row[C_SU + ch]), z = bf2f(row[C_SZ + ch]);
            row[C_SU + ch] = (bf16_t)f2bf(gelu_f(u) * s * silu_f(z));
        }
    }
}
__device__ __forceinline__ void phase_gdn_prep(KA a, int l, int bid, int G) {
    const int wave = TIDX() >> 6, lane = TIDX() & 63;
    const bf16_t* P = (const bf16_t*)(a->ws + WS_P); const float* EXT = (const float*)(a->ws + WS_EXT);
    bf16_t* GQ = (bf16_t*)(a->ws + WS_GQ); bf16_t* GK = (bf16_t*)(a->ws + WS_GK); bf16_t* GV = (bf16_t*)(a->ws + WS_GV); float* GB = (float*)(a->ws + WS_GB);
    const float* cw = a->gdn_conv_w + (size_t)l * 3 * 768;
    for (int it = bid * 8 + wave; it < RT * 4; it += G * 8) {
        const int r = it >> 2, h = it & 3, chn = h * 64 + lane; const bool is_ctx = r >= RL; const int t = is_ctx ? ((r - RL) & 255) : (r & 2047), len = is_ctx ? TC : TL;
        const bf16_t* row = P + (size_t)r * PW;
        float q = 0.f, k = 0.f, v = 0.f;
#pragma unroll
        for (int d = 0; d < 3; ++d) { const int tt = t + d - 1; if (tt >= 0 && tt < len) { const bf16_t* rp = row + (ptrdiff_t)(d - 1) * PW;
            q += cw[d * 768 + chn] * bf2f(rp[C_GQ + chn]); k += cw[d * 768 + 256 + chn] * bf2f(rp[C_GK + chn]); v += cw[d * 768 + 512 + chn] * bf2f(rp[C_GV + chn]); } }
        q = silu_f(q); k = silu_f(k); v = silu_f(v);
        const float qs = rsqrtf(wave_sum(q * q) + EPS), ksn = rsqrtf(wave_sum(k * k) + EPS);
        GQ[(size_t)r * 256 + chn] = (bf16_t)f2bf(q * qs * 0.125f); GK[(size_t)r * 256 + chn] = (bf16_t)f2bf(k * ksn); GV[(size_t)r * 256 + chn] = (bf16_t)f2bf(v);
        if (lane < 4) { const int dir = lane & 1; const float e = EXT[(size_t)r * 16 + (lane >> 1) * 8 + dir * 4 + h]; float o;
            if (lane < 2) o = -__expf(a->gdn_a_log[(l * 2 + dir) * 4 + h]) * softplus_f(e + a->gdn_dt_bias[(l * 2 + dir) * 4 + h]); else o = sigmoid_f(e);
            GB[((size_t)r * 4 + h) * 4 + lane] = o; }
    }
}
__device__ __forceinline__ void phase_gdn_rec(KA a, int l, LAS unsigned char* lds, int bid, int G) {
    const int wave = TIDX() >> 6, lane = TIDX() & 63;
    const bf16_t* GQ = (const bf16_t*)(a->ws + WS_GQ); const bf16_t* GK = (const bf16_t*)(a->ws + WS_GK); const bf16_t* GV = (const bf16_t*)(a->ws + WS_GV); const float* GB = (const float*)(a->ws + WS_GB);
    float* OG = (float*)(a->ws + WS_OG);
    LAS float* qk = (LAS float*)lds + wave * 128;
    for (int ch = bid * 8 + wave; ch < NB * 4 * 2; ch += G * 8) {
        const int b = ch >> 3, h = (ch >> 1) & 3, dir = ch & 1;
        float S[64];
#pragma unroll
        for (int d = 0; d < 64; ++d) S[d] = 0.f;
        float* og = OG + (size_t)dir * RT * 256;
        auto sidx = [&](int i) { return dir == 0 ? i : (i < TC ? TC - 1 - i : (TC + TL - 1) - (i - TC)); };
        int r = seq_row(b, sidx(0));
        float qn = bf2f(GQ[(size_t)r * 256 + h * 64 + lane]), kn = bf2f(GK[(size_t)r * 256 + h * 64 + lane]), vn = bf2f(GV[(size_t)r * 256 + h * 64 + lane]);
        float gn = GB[((size_t)r * 4 + h) * 4 + dir], bn = GB[((size_t)r * 4 + h) * 4 + 2 + dir];
        for (int i = 0; i < TC + TL; ++i) {
            const float q = qn, k = kn, v = vn, g = gn, be = bn; const int rc = r;
            if (i + 1 < TC + TL) { r = seq_row(b, sidx(i + 1));
                qn = bf2f(GQ[(size_t)r * 256 + h * 64 + lane]); kn = bf2f(GK[(size_t)r * 256 + h * 64 + lane]); vn = bf2f(GV[(size_t)r * 256 + h * 64 + lane]);
                gn = GB[((size_t)r * 4 + h) * 4 + dir]; bn = GB[((size_t)r * 4 + h) * 4 + 2 + dir]; }
            qk[lane] = q; qk[64 + lane] = k;
            asm volatile("s_waitcnt lgkmcnt(0)" ::: "memory");
            const float dec = __expf(g); float kS = 0.f;
#pragma unroll
            for (int d4 = 0; d4 < 16; ++d4) { const f32x4 k4 = *(const LAS f32x4*)(qk + 64 + d4 * 4);
#pragma unroll
                for (int e = 0; e < 4; ++e) { S[d4 * 4 + e] *= dec; kS += k4[e] * S[d4 * 4 + e]; } }
            const float delta = be * (v - kS); float o = 0.f;
#pragma unroll
            for (int d4 = 0; d4 < 16; ++d4) { const f32x4 k4 = *(const LAS f32x4*)(qk + 64 + d4 * 4), q4 = *(const LAS f32x4*)(qk + d4 * 4);
#pragma unroll
                for (int e = 0; e < 4; ++e) { S[d4 * 4 + e] += k4[e] * delta; o += q4[e] * S[d4 * 4 + e]; } }
            og[(size_t)rc * 256 + h * 64 + lane] = o;
            asm volatile("s_waitcnt lgkmcnt(0)" ::: "memory");
        }
    }
}
__device__ __forceinline__ void phase_gdn_fin(KA a, int l, int bid, int G) {
    const int wave = TIDX() >> 6, lane = TIDX() & 63;
    bf16_t* P = (bf16_t*)(a->ws + WS_P); const float* OG = (const float*)(a->ws + WS_OG);
    const int nrows = (l == DEPTH - 1) ? RL : RT; const float ng = a->gdn_norm_g[l * 64 + lane];
    for (int it = bid * 8 + wave; it < nrows * 4; it += G * 8) {
        const int r = it >> 2, h = it & 3; const size_t oi = (size_t)r * 256 + h * 64 + lane;
        const float o = OG[oi] + OG[(size_t)RT * 256 + oi];
        const float rs = rsqrtf(wave_sum(o * o) * (1.f / 64.f) + EPS);
        bf16_t* zp = P + (size_t)r * PW + C_GZ + h * 64 + lane;
        *zp = (bf16_t)f2bf(o * rs * ng * silu_f(bf2f(*zp)));
    }
}
__device__ __forceinline__ void phase_ret_rec(KA a, int l, LAS unsigned char* lds, int bid, int G) {
    const int wave = TIDX() >> 6, lane = TIDX() & 63;
    const bf16_t* P = (const bf16_t*)(a->ws + WS_P); float* RO = (float*)(a->ws + WS_OG); const float* rope = (const float*)(a->ws + WS_ROPE);
    LAS float* qk = (LAS float*)lds + wave * 128;
    for (int ch = bid * 8 + wave; ch < NB * 4 * 2; ch += G * 8) {
        const int b = ch >> 3, h = (ch >> 1) & 3, dir = ch & 1;
        const float gamma = 1.f - exp2f(-5.f - (float)h);
        float S[64];
#pragma unroll
        for (int d = 0; d < 64; ++d) S[d] = 0.f;
        float* ro = RO + (size_t)dir * RT * 256;
        auto sidx = [&](int i) { return dir == 0 ? i : (i < TC ? TC - 1 - i : (TC + TL - 1) - (i - TC)); };
        const int f = lane & 15; const bool hi = (lane & 16) != 0, colhalf = lane >= 32;
        int s = sidx(0), r = seq_row(b, s);
        float qn = bf2f(P[(size_t)r * PW + C_RQ + h * 64 + lane]), kn = bf2f(P[(size_t)r * PW + C_RK + h * 64 + lane]), vn = bf2f(P[(size_t)r * PW + C_RV + h * 64 + lane]);
        for (int i = 0; i < TC + TL; ++i) {
            float q = qn, k = kn; const float v = vn; const int rc = r, sc = s;
            if (i + 1 < TC + TL) { s = sidx(i + 1); r = seq_row(b, s);
                qn = bf2f(P[(size_t)r * PW + C_RQ + h * 64 + lane]); kn = bf2f(P[(size_t)r * PW + C_RK + h * 64 + lane]); vn = bf2f(P[(size_t)r * PW + C_RV + h * 64 + lane]); }
            if (sc >= TC) { const int t = sc - TC, pos = colhalf ? (t & 63) : (t >> 6); const float cs = rope[pos * 16 + f], sn = rope[1024 + pos * 16 + f];
                const float qp = __shfl_xor(q, 16), kp = __shfl_xor(k, 16);
                q = hi ? (qp * sn + q * cs) : (q * cs - qp * sn); k = hi ? (kp * sn + k * cs) : (k * cs - kp * sn); }
            k *= 0.125f;
            qk[lane] = q; qk[64 + lane] = k;
            asm volatile("s_waitcnt lgkmcnt(0)" ::: "memory");
            float o = 0.f;
#pragma unroll
            for (int d4 = 0; d4 < 16; ++d4) { const f32x4 k4 = *(const LAS f32x4*)(qk + 64 + d4 * 4), q4 = *(const LAS f32x4*)(qk + d4 * 4);
#pragma unroll
                for (int e = 0; e < 4; ++e) { S[d4 * 4 + e] = gamma * S[d4 * 4 + e] + k4[e] * v; o += q4[e] * S[d4 * 4 + e]; } }
            ro[(size_t)rc * 256 + h * 64 + lane] = o;
            asm volatile("s_waitcnt lgkmcnt(0)" ::: "memory");
        }
    }
}
__device__ __forceinline__ void phase_ret_fin(KA a, int l, int bid, int G) {
    const int wave = TIDX() >> 6, lane = TIDX() & 63;
    bf16_t* P = (bf16_t*)(a->ws + WS_P); const float* RO = (const float*)(a->ws + WS_OG);
    const int nrows = (l == DEPTH - 1) ? RL : RT;
    for (int it = bid * 8 + wave; it < nrows * 4; it += G * 8) {
        const int r = it >> 2, h = it & 3; const size_t oi = (size_t)r * 256 + h * 64 + lane;
        float o = RO[oi] + RO[(size_t)RT * 256 + oi];
        const float mu = wave_sum(o) * (1.f / 64.f); o -= mu;
        const float rs = rsqrtf(wave_sum(o * o) * (1.f / 64.f) + EPS);
        const float z = bf2f(P[(size_t)r * PW + C_RZ + h * 64 + lane]);
        P[(size_t)r * PW + C_RQ + h * 64 + lane] = (bf16_t)f2bf(o * rs * a->ret_norm_g[l * 256 + h * 64 + lane] * silu_f(z));
    }
}

constexpr int STEPS_PER_LAYER = 11, N_STEPS = 1 + DEPTH * STEPS_PER_LAYER + 1;

__global__ void __launch_bounds__(512, 2) fwd_megakernel(Args a) {
    extern __shared__ __attribute__((aligned(16))) unsigned char lds_raw[];
    LAS unsigned char* lds = (LAS unsigned char*)lds_raw;
    cg::grid_group grid = cg::this_grid();
    const int bid = blockIdx.x, G = gridDim.x;
    const int st_lo = a.st_lo, st_hi = a.st_hi, coop = a.coop;
    KA ka = (KA)__builtin_amdgcn_kernarg_segment_ptr();
#define STEP(idx, call) do { const int _i = (idx); if (st_lo <= _i && _i < st_hi) { call; if (_i + 1 < st_hi) { if (coop) grid.sync(); else __syncthreads(); } } } while (0)
    STEP(0, phase_prologue(ka, lds, bid, G));
#pragma unroll
    for (int l = 0; l < DEPTH; ++l) {
        const int s0 = 1 + l * STEPS_PER_LAYER;
        STEP(s0 + 0, phase_norm(ka, l, bid, G));
        STEP(s0 + 1, phase_gemm(ka, l, false, lds, bid, G));
        STEP(s0 + 2, phase_gdn_prep(ka, l, bid, G));
        STEP(s0 + 3, phase_gdn_rec(ka, l, lds, bid, G));
        STEP(s0 + 4, phase_gdn_fin(ka, l, bid, G));
        STEP(s0 + 5, phase_ret_rec(ka, l, lds, bid, G));
        STEP(s0 + 6, phase_ret_fin(ka, l, bid, G));
        STEP(s0 + 7, phase_sg1(ka, l, bid, G));
        STEP(s0 + 8, phase_sg2(ka, l, lds, bid, G));
        STEP(s0 + 9, phase_sc(ka, l, bid, G));
        STEP(s0 + 10, phase_gemm(ka, l, true, lds, bid, G));
    }
    STEP(N_STEPS - 1, phase_norm(ka, DEPTH, bid, G));
#undef STEP
}

extern "C" void kernel_launch(void* const* d_in, const int* in_sizes, int n_in, void* d_out, int out_size, void* d_ws, size_t ws_size, hipStream_t stream) {
    static int grid = 0;
    if (grid == 0) {
        int dev = 0, cus = 0, per_cu = 0;
        hipGetDevice(&dev); hipDeviceGetAttribute(&cus, hipDeviceAttributeMultiprocessorCount, dev);
        if (hipFuncSetAttribute((const void*)fwd_megakernel, hipFuncAttributeMaxDynamicSharedMemorySize, LDS_BYTES) != hipSuccess) { fprintf(stderr, "hipFuncSetAttribute failed\n"); grid = -1; return; }
        if (hipOccupancyMaxActiveBlocksPerMultiprocessor(&per_cu, (const void*)fwd_megakernel, 512, LDS_BYTES) != hipSuccess || per_cu < 1) { fprintf(stderr, "occupancy query failed (%d)\n", per_cu); per_cu = 1; }
        (void)hipGetLastError();
        grid = cus * per_cu;
        if (ws_size < WS_END) { fprintf(stderr, "workspace too small: %zu < %zu\n", ws_size, (size_t)WS_END); grid = -1; return; }
    }
    if (grid < 0) return;
    Args a{};
    const float** ap = (const float**)&a;
    for (int i = 0; i < 18; ++i) ap[i] = (const float*)d_in[i];
    a.out = (float*)d_out; a.ws = (unsigned char*)d_ws;
    hipMemsetAsync((char*)d_ws + WS_CTL, 0, 4096, stream);
#if MK_MULTI
    for (int st = 0; st < N_STEPS; ++st) { a.st_lo = st; a.st_hi = st + 1; a.coop = 0; hipLaunchKernelGGL(fwd_megakernel, dim3(grid), dim3(512), LDS_BYTES, stream, a); }
#else
    a.st_lo = 0; a.st_hi = N_STEPS; a.coop = 1;
    void* args[] = {&a};
    hipError_t e = hipLaunchCooperativeKernel((const void*)fwd_megakernel, dim3(grid), dim3(512), args, LDS_BYTES, stream);
    if (e != hipSuccess) fprintf(stderr, "cooperative launch failed: %s (grid %d)\n", hipGetErrorString(e), grid);
#endif
}
```

```cpp
#include <hip/hip_runtime.h>
#include <hip/hip_cooperative_groups.h>
#include <cstdint>
#include <cstdio>
namespace cg = cooperative_groups;

#ifndef EXP_NOINPLACE
#define EXP_NOINPLACE 0
#endif
#ifndef EXP_NJ
#define EXP_NJ 18
#endif
#ifndef OPT_GDN
#define OPT_GDN 1
#endif
#ifndef OPT_RET
#define OPT_RET 1
#endif
#ifndef MK_MULTI
#define MK_MULTI 0
#endif

#define LAS __attribute__((address_space(3)))
__device__ __forceinline__ int TIDX() { int t = threadIdx.x; asm volatile("" : "+v"(t)); return t; }
typedef unsigned short bf16_t;
typedef short bf16x8 __attribute__((ext_vector_type(8)));
typedef float f32x4 __attribute__((ext_vector_type(4)));
typedef float f32x2 __attribute__((ext_vector_type(2)));
typedef unsigned u32x4 __attribute__((ext_vector_type(4)));
typedef unsigned u32x2 __attribute__((ext_vector_type(2)));

constexpr int DM = 1024, NB = 16, TL = 2048, TC = 256, DEPTH = 4;
constexpr int RL = NB * TL, RC = NB * TC, RT = RL + RC;
constexpr int PW = 3840, INW = 3856;
constexpr float EPS = 1e-6f;
constexpr unsigned long long POSPACK = 0xCEDBA9786543210ull;
constexpr int C_RQ = 0, C_RK = 256, C_RV = 512, C_RZ = 768, C_SU = 1024, C_SV = 1280, C_SZ = 1536, C_CC = 1792, C_CB = 2048, C_CH = 2304, C_CZ = 2560,
              C_GQ = 2816, C_GZ = 3072, C_GK = 3328, C_GV = 3584;

constexpr size_t MiB = 1u << 20;
constexpr size_t WS_CTL = 0;
constexpr size_t WS_ROPE = 512 * 1024;
constexpr size_t WS_MOD = 1 * MiB;
constexpr size_t WS_WEXT = 2 * MiB;
constexpr size_t WS_WIN = 3 * MiB;
constexpr size_t WS_WOUT = 33 * MiB;
constexpr size_t WS_XC = 41 * MiB;
constexpr size_t WS_EXT = 57 * MiB;
constexpr size_t WS_KV = 60 * MiB;
constexpr size_t WS_X = 78 * MiB;
constexpr size_t WS_O = WS_X, WS_H = WS_X + 72 * MiB;
constexpr size_t WS_P = 222 * MiB;
constexpr size_t WS_GB = 492 * MiB;
constexpr size_t WS_END = 495 * MiB;
constexpr size_t WS_OG = WS_X;
constexpr size_t WS_GQ = WS_X + 72 * MiB, WS_GK = WS_GQ + 18 * MiB, WS_GV = WS_GK + 18 * MiB;
constexpr size_t WS_SGV = WS_X + 72 * MiB;

constexpr int LDS_BYTES = 147456;

struct Args {
    const float *x, *c, *ctx, *c_ctx, *w_mod, *b_mod, *g_pre, *g_post, *w_in, *w_out, *ret_norm_g, *sg_w, *sg_b, *sc_conv_w, *gdn_conv_w, *gdn_a_log, *gdn_dt_bias, *gdn_norm_g;
    float* out; unsigned char* ws; int st_lo, st_hi, coop, pad;
};

typedef const __attribute__((address_space(4))) Args* KA;

__device__ __forceinline__ float bf2f(unsigned v) { return __uint_as_float(v << 16); }
typedef __bf16 bf16v2_t __attribute__((ext_vector_type(2)));
__device__ __forceinline__ unsigned cvt_pk_bf16(float lo, float hi) { const f32x2 f = {lo, hi}; return __builtin_bit_cast(unsigned, __builtin_convertvector(f, bf16v2_t)); }
__device__ __forceinline__ unsigned f2bf(float f) { return cvt_pk_bf16(f, 0.f) & 0xffffu; }
__device__ __forceinline__ float wave_sum(float v) {
#pragma unroll
    for (int o = 1; o < 64; o <<= 1) v += __shfl_xor(v, o);
    return v;
}
__device__ __forceinline__ float silu_f(float x) { return x / (1.f + __expf(-x)); }
__device__ __forceinline__ float gelu_f(float x) { const float u = 0.7978845608028654f * (x + 0.044715f * x * x * x); return 0.5f * x * (1.f + tanhf(u)); }
__device__ __forceinline__ float softplus_f(float x) { return x > 20.f ? x : log1pf(__expf(x)); }
__device__ __forceinline__ float sigmoid_f(float x) { return 1.f / (1.f + __expf(-x)); }

namespace pg8 {
constexpr int BM = 256, BK = 64, HALF = 128, HTB = HALF * BK * 2, STAGE_BYTES = 8 * HTB, NXCD = 8, WGM = 8;
__host__ __device__ __forceinline__ int lds_byte(int r, int c) { const int st = (r >> 4) * 2 + (c >> 5), rr = r & 15, cc = c & 31, ob = rr * 64 + cc * 2; return st * 1024 + (ob ^ (((ob >> 9) & 1) << 5)); }
__host__ __device__ __forceinline__ void stage_rc(int b, int& R, int& C) { const int st = b / 1024, sb = b % 1024, swz = sb ^ (((sb >> 9) & 1) << 5); R = (st >> 1) * 16 + swz / 64; C = (st & 1) * 32 + (swz % 64) / 2; }
__host__ __device__ __forceinline__ int perm32(int rho) { const int n = rho >> 4, i = rho & 15; return 8 * (i >> 2) + 4 * n + (i & 3); }
struct Unit { int pm, pn; };
struct Gemm { const bf16_t* A; const bf16_t* Bt; int M, N, K, lda, seg; };
struct StaticOrder {
    int nM, nN, nwg, G, c;
    __host__ __device__ void init(int M, int N, int G_, int c_) { nM = M / BM; nN = N / BM; nwg = nM * nN; G = G_; c = c_; }
    __host__ __device__ bool next(int i, Unit& u) const {
        const long L = (long)i * G + c; if (L >= nwg) return false;
        int wgid = (int)L; { const int q = nwg / NXCD, r = nwg % NXCD, xcd = wgid % NXCD, off = wgid / NXCD; wgid = (xcd < r ? xcd * (q + 1) : r * (q + 1) + (xcd - r) * q) + off; }
        const int nig = WGM * nN, gid = wgid / nig, fm = gid * WGM, gsz = (nM - fm) < WGM ? (nM - fm) : WGM;
        u.pm = fm + ((wgid % nig) % gsz); u.pn = (wgid % nig) / gsz; return true;
    }
};
struct EpiBf16 {
    bf16_t* O; int ldc;
    __device__ __forceinline__ void operator()(const f32x4 (&acc)[2][2][4][2], const Unit& u, int wr, int wc, int fr, int fq) const {
        const int row0 = u.pm * BM + wr * 64 + fr, col0 = u.pn * BM + wc * 32 + 8 * fq;
#pragma unroll
        for (int ai = 0; ai < 2; ++ai)
#pragma unroll
            for (int m = 0; m < 4; ++m) { bf16_t* rowp = O + (size_t)(row0 + ai * HALF + m * 16) * ldc + col0;
#pragma unroll
                for (int bj = 0; bj < 2; ++bj) { const f32x4 v0 = acc[ai][bj][m][0], v1 = acc[ai][bj][m][1];
                    u32x4 w; w.x = cvt_pk_bf16(v0[0], v0[1]); w.y = cvt_pk_bf16(v0[2], v0[3]); w.z = cvt_pk_bf16(v1[0], v1[1]); w.w = cvt_pk_bf16(v1[2], v1[3]);
                    *(u32x4*)(rowp + bj * HALF) = w; } }
    }
};

template <class Epi>
__device__ __forceinline__ void gemm_phase(LAS unsigned char* lds, const Gemm g, const StaticOrder& S, const Epi& E) {
    const int tid = TIDX(), wid = __builtin_amdgcn_readfirstlane(tid >> 6), lane = tid & 63, wr = wid >> 2, wc = wid & 3, fr = lane & 15, fq = lane >> 4;
    const int K = g.K, nt = K / BK, lda = g.lda, seg = g.seg;
    unsigned voffA[2], voffB[2];
#pragma unroll
    for (int i = 0; i < 2; ++i) { int R, C; stage_rc(tid * 16 + i * 8192, R, C); const int Rb = (R & ~31) + perm32(R & 31);
        voffA[i] = (unsigned)(R * lda + C) * 2u; voffB[i] = (unsigned)(Rb * K + C) * 2u; }
    const size_t kstep = (size_t)(BK * 2);
    const size_t hstepA = (size_t)HALF * lda * 2, hstepB = (size_t)HALF * K * 2;
    const size_t tstepA = 2 * hstepA, tstepB = 2 * hstepB;
#define KOFFA(t) (seg ? ((size_t)((t) >> 2) * 2048 + (size_t)((t) & 3) * 128) : (size_t)(t) * 128)
    const unsigned ldsw = (unsigned)wid * 1024u;
    const int aoff = lds_byte(wr * 64 + fr, fq * 8), boff = lds_byte(wc * 32 + fr, fq * 8);
#define PG8_SA(b, h) (((b) * 2 + (h)) * HTB)
#define PG8_SB(b, h) ((4 + (b) * 2 + (h)) * HTB)
#define PG8_STAGE(bufoff, gbase, voff) do { _Pragma("unroll") for (int _i = 0; _i < 2; ++_i) \
        __builtin_amdgcn_global_load_lds((const unsigned*)((const char*)(gbase) + (voff)[_i]), (LAS unsigned*)(lds + (bufoff) + ldsw + _i * 8192), 16, 0, 0); } while (0)
#define PG8_LDA(dst, b, h) do { _Pragma("unroll") for (int m = 0; m < 4; ++m) _Pragma("unroll") for (int k = 0; k < 2; ++k) dst[m][k] = *(const LAS bf16x8*)(lds + PG8_SA(b, h) + aoff + m * 2048 + k * 1024); } while (0)
#define PG8_LDB(dst, b, h) do { _Pragma("unroll") for (int n = 0; n < 2; ++n) _Pragma("unroll") for (int k = 0; k < 2; ++k) dst[n][k] = *(const LAS bf16x8*)(lds + PG8_SB(b, h) + boff + n * 2048 + k * 1024); } while (0)
#define PG8_MMA(ai, bj, At, Bt) do { __builtin_amdgcn_s_setprio(1); _Pragma("unroll") for (int m = 0; m < 4; ++m) _Pragma("unroll") for (int n = 0; n < 2; ++n) _Pragma("unroll") for (int k = 0; k < 2; ++k) \
        acc[ai][bj][m][n] = __builtin_amdgcn_mfma_f32_16x16x32_bf16(Bt[n][k], At[m][k], acc[ai][bj][m][n], 0, 0, 0); __builtin_amdgcn_s_setprio(0); } while (0)
#define PG8_WAIT_V(n) asm volatile("s_waitcnt vmcnt(" #n ")" ::: "memory")
#define PG8_WAIT_L(n) asm volatile("s_waitcnt lgkmcnt(" #n ")" ::: "memory")
#define PG8_BAR __builtin_amdgcn_s_barrier()
#define PG8_SCHED __builtin_amdgcn_sched_barrier(0)
    Unit cur, nxt; int ui = 0;
    if (!S.next(0, cur)) return;
    f32x4 acc[2][2][4][2];
#pragma unroll
    for (int a = 0; a < 2; ++a)
#pragma unroll
        for (int b = 0; b < 2; ++b)
#pragma unroll
            for (int m = 0; m < 4; ++m)
#pragma unroll
                for (int n = 0; n < 2; ++n) acc[a][b][m][n] = (f32x4){0.f, 0.f, 0.f, 0.f};
    bf16x8 At[4][2], B0[2][2], B1[2][2];
    const char* cA = (const char*)g.A + (size_t)cur.pm * tstepA; const char* cB = (const char*)g.Bt + (size_t)cur.pn * tstepB;
    PG8_STAGE(PG8_SB(0, 0), cB, voffB); PG8_STAGE(PG8_SB(0, 1), cB + hstepB, voffB); PG8_STAGE(PG8_SA(0, 0), cA, voffA); PG8_STAGE(PG8_SA(0, 1), cA + hstepA, voffA);
    if (wr == 1) PG8_BAR;
    PG8_WAIT_V(2); PG8_BAR;
    PG8_STAGE(PG8_SB(1, 0), cB + kstep, voffB); PG8_STAGE(PG8_SA(1, 0), cA + KOFFA(1), voffA); PG8_STAGE(PG8_SB(1, 1), cB + hstepB + kstep, voffB);
    PG8_WAIT_V(6); PG8_BAR;
    for (;;) {
        const bool has_next = S.next(ui + 1, nxt);
        const char* nA = has_next ? (const char*)g.A + (size_t)nxt.pm * tstepA : cA; const char* nB = has_next ? (const char*)g.Bt + (size_t)nxt.pn * tstepB : cB;
        for (int t = 0; t < nt; t += 2) {
            const bool last = (t == nt - 2);
            const char* a1 = cA + KOFFA(t + 1);
            const char* a2 = last ? nA : cA + KOFFA(t + 2); const char* b2 = last ? nB : cB + (size_t)(t + 2) * kstep;
            const char* a3 = last ? nA + KOFFA(1) : cA + KOFFA(t + 3); const char* b3 = b2 + kstep;
            PG8_LDB(B0, 0, 0); PG8_LDB(B1, 0, 1); PG8_SCHED; PG8_LDA(At, 0, 0); PG8_STAGE(PG8_SA(1, 1), a1 + hstepA, voffA);
            PG8_WAIT_V(8); PG8_WAIT_L(0); PG8_BAR; PG8_MMA(0, 0, At, B0); PG8_MMA(0, 1, At, B1); PG8_BAR; PG8_SCHED;
            PG8_LDA(At, 0, 1); PG8_STAGE(PG8_SB(0, 0), b2, voffB); PG8_STAGE(PG8_SB(0, 1), b2 + hstepB, voffB); PG8_STAGE(PG8_SA(0, 0), a2, voffA);
            PG8_WAIT_V(8); PG8_WAIT_L(0); PG8_BAR; PG8_MMA(1, 0, At, B0); PG8_MMA(1, 1, At, B1); PG8_BAR; PG8_SCHED;
            PG8_LDB(B0, 1, 0); PG8_LDB(B1, 1, 1); PG8_SCHED; PG8_LDA(At, 1, 0); PG8_STAGE(PG8_SA(0, 1), a2 + hstepA, voffA);
            PG8_WAIT_V(8); PG8_WAIT_L(0); PG8_BAR; PG8_MMA(0, 0, At, B0); PG8_MMA(0, 1, At, B1); PG8_BAR; PG8_SCHED;
            PG8_LDA(At, 1, 1); PG8_STAGE(PG8_SB(1, 0), b3, voffB); PG8_STAGE(PG8_SB(1, 1), b3 + hstepB, voffB); PG8_STAGE(PG8_SA(1, 0), a3, voffA);
            PG8_WAIT_V(8); PG8_WAIT_L(0); PG8_BAR; PG8_MMA(1, 0, At, B0); PG8_MMA(1, 1, At, B1); PG8_BAR; PG8_SCHED;
        }
        if (wr == 0) PG8_BAR;
        E(acc, cur, wr, wc, fr, fq);
        if (!has_next) break;
#pragma unroll
        for (int a = 0; a < 2; ++a)
#pragma unroll
            for (int b = 0; b < 2; ++b)
#pragma unroll
                for (int m = 0; m < 4; ++m)
#pragma unroll
                    for (int n = 0; n < 2; ++n) acc[a][b][m][n] = (f32x4){0.f, 0.f, 0.f, 0.f};
        cur = nxt; cA = nA; cB = nB; ++ui;
        if (wr == 1) PG8_BAR;
    }
    PG8_WAIT_V(0);
    PG8_BAR;
#undef KOFFA
#undef PG8_SA
#undef PG8_SB
#undef PG8_STAGE
#undef PG8_LDA
#undef PG8_LDB
#undef PG8_MMA
#undef PG8_WAIT_V
#undef PG8_WAIT_L
#undef PG8_BAR
#undef PG8_SCHED
}
}

__device__ __forceinline__ int seq_row(int b, int s) { return s < TC ? RL + b * TC + s : b * TL + (s - TC); }

__device__ __forceinline__ void transpose_item(const float* W, int N, int item, int nblk, bf16_t* dst_main, bf16_t* dst_ext, bool is_in, LAS float* scr, int lane) {
    const int kb = item / nblk, nb = item % nblk, k0 = 64 * kb, n0 = 32 * nb;
    { const int n = n0 + (lane & 31);
#pragma unroll 8
      for (int i = 0; i < 32; ++i) { const int kk = 2 * i + (lane >> 5); scr[kk * 33 + (lane & 31)] = n < N ? W[(size_t)(k0 + kk) * N + n] : 0.f; } }
    asm volatile("s_waitcnt lgkmcnt(0)" ::: "memory");
    const int c = lane & 7;
#pragma unroll
    for (int j = 0; j < 4; ++j) { const int nl = (lane >> 3) + 8 * j, n = n0 + nl; const LAS float* s = scr + (8 * c) * 33 + nl;
        u32x4 o; o.x = cvt_pk_bf16(s[0 * 33], s[1 * 33]); o.y = cvt_pk_bf16(s[2 * 33], s[3 * 33]); o.z = cvt_pk_bf16(s[4 * 33], s[5 * 33]); o.w = cvt_pk_bf16(s[6 * 33], s[7 * 33]);
        if (n < N) { bf16_t* rowp;
            if (is_in) { if (n < PW) { const int sg = n >> 8, pos = (int)((POSPACK >> (4 * sg)) & 15ull); rowp = dst_main + (size_t)(pos * 256 + (n & 255)) * DM; } else rowp = dst_ext + (size_t)(n - PW) * DM; }
            else rowp = dst_main + (size_t)n * DM;
            *(u32x4*)(rowp + k0 + 8 * c) = o; } }
    asm volatile("s_waitcnt lgkmcnt(0)" ::: "memory");
}

__device__ __forceinline__ void phase_prologue(KA a, LAS unsigned char* lds, int bid, int G) {
    const int tid = TIDX(), wave = tid >> 6, lane = tid & 63;
    unsigned char* ws = a->ws;
    if (bid == G - 1) { float* rope = (float*)(ws + WS_ROPE);
        for (int i = tid; i < 1024; i += 512) { const int pos = i >> 4, f = i & 15; const float inv = expf(-9.210340371976184f * (float)f * (1.f / 16.f)); const float ang = (float)pos * inv;
            rope[i] = cosf(ang); rope[1024 + i] = sinf(ang); } }
    for (int it = bid; it < 96; it += G) {
        LAS float* s = (LAS float*)lds;
        for (int i = tid; i < 17 * 1024; i += 512) { const int r = i >> 10, k = i & 1023; const float v = r < 16 ? a->c[r * 1024 + k] : a->c_ctx[k]; s[i] = silu_f(v); }
        __syncthreads();
        const int l = it / 24, j0 = (it % 24) * 128;
        f32x2 acc[17];
#pragma unroll
        for (int r = 0; r < 17; ++r) acc[r] = (f32x2){0.f, 0.f};
        const float* wp = a->w_mod + ((size_t)l * 1024 + wave * 128) * 3072 + j0 + lane * 2;
#pragma unroll 4
        for (int k = 0; k < 128; ++k) { const f32x2 w2 = *(const f32x2*)(wp + (size_t)k * 3072);
#pragma unroll
            for (int r = 0; r < 17; ++r) { const float sv = s[r * 1024 + wave * 128 + k]; acc[r] += sv * w2; } }
        __syncthreads();
        LAS float* part = (LAS float*)lds;
#pragma unroll
        for (int r = 0; r < 17; ++r) *(LAS f32x2*)(part + (wave * 17 + r) * 128 + lane * 2) = acc[r];
        __syncthreads();
        float* mod = (float*)(ws + WS_MOD);
        for (int i = tid; i < 17 * 128; i += 512) { const int r = i >> 7, cc = i & 127; float v = a->b_mod[l * 3072 + j0 + cc];
#pragma unroll
            for (int w = 0; w < 8; ++w) v += part[(w * 17 + r) * 128 + cc];
            mod[((size_t)l * 17 + r) * 3072 + j0 + cc] = v; }
        __syncthreads();
    }
    __syncthreads();
    LAS float* scr = (LAS float*)lds + wave * (64 * 33);
    const int gw = bid * 8 + wave, NGW = G * 8;
    constexpr int I_IN = 16 * 121, I_OUT = 16 * 32, NIT = DEPTH * (I_IN + I_OUT);
    for (int it = gw; it < NIT; it += NGW) {
        const int l = it / (I_IN + I_OUT), r = it % (I_IN + I_OUT);
        if (r < I_IN) transpose_item(a->w_in + (size_t)l * DM * INW, INW, r, 121, (bf16_t*)(ws + WS_WIN) + (size_t)l * PW * DM, (bf16_t*)(ws + WS_WEXT) + (size_t)l * 16 * DM, true, scr, lane);
        else transpose_item(a->w_out + (size_t)l * DM * DM, DM, r - I_IN, 32, (bf16_t*)(ws + WS_WOUT) + (size_t)l * DM * DM, nullptr, false, scr, lane);
    }
}

__device__ __forceinline__ void phase_norm(KA a, int l, int bid, int G) {
    const int tid = TIDX(), wave = tid >> 6, lane = tid & 63;
    unsigned char* ws = a->ws;
    const float* mod = (const float*)(ws + WS_MOD);
    const bf16_t* O = (const bf16_t*)(ws + WS_O); bf16_t* H = (bf16_t*)(ws + WS_H); float* XC = (float*)(ws + WS_XC);
    const int nrows = (l == DEPTH) ? RL : RT;
    for (int r = bid * 8 + wave; r < nrows; r += G * 8) {
        const bool is_ctx = r >= RL; const int mr = is_ctx ? 16 : (r >> 11);
        const float* xp = (l <= 1) ? (is_ctx ? a->ctx + (size_t)(r - RL) * DM : a->x + (size_t)r * DM) : (is_ctx ? XC + (size_t)(r - RL) * DM : a->out + (size_t)r * DM);
        f32x4 v[4];
#pragma unroll
        for (int j = 0; j < 4; ++j) v[j] = *(const f32x4*)(xp + 4 * lane + 256 * j);
        if (l > 0) {
            f32x4 o[4]; float ss = 0.f;
#pragma unroll
            for (int j = 0; j < 4; ++j) { const u32x2 w = *(const u32x2*)(O + (size_t)r * DM + 4 * lane + 256 * j);
                o[j] = (f32x4){bf2f(w.x & 0xffffu), bf2f(w.x >> 16), bf2f(w.y & 0xffffu), bf2f(w.y >> 16)};
                ss += o[j][0] * o[j][0] + o[j][1] * o[j][1] + o[j][2] * o[j][2] + o[j][3] * o[j][3]; }
            const float rs = rsqrtf(wave_sum(ss) * (1.f / DM) + EPS);
            const float* gate = mod + ((size_t)(l - 1) * 17 + mr) * 3072 + 2048; const float* gp = a->g_post + (size_t)(l - 1) * DM;
            float* xo = is_ctx ? XC + (size_t)(r - RL) * DM : a->out + (size_t)r * DM;
#pragma unroll
            for (int j = 0; j < 4; ++j) { const int col = 4 * lane + 256 * j; const f32x4 gt = *(const f32x4*)(gate + col), g4 = *(const f32x4*)(gp + col);
                v[j] += gt * (o[j] * rs * g4); *(f32x4*)(xo + col) = v[j]; }
        }
        if (l < DEPTH) {
            float ss = 0.f;
#pragma unroll
            for (int j = 0; j < 4; ++j) ss += v[j][0] * v[j][0] + v[j][1] * v[j][1] + v[j][2] * v[j][2] + v[j][3] * v[j][3];
            const float rs = rsqrtf(wave_sum(ss) * (1.f / DM) + EPS);
            const float* mrow = mod + ((size_t)l * 17 + mr) * 3072; const float* gpre = a->g_pre + (size_t)l * DM;
#pragma unroll
            for (int j = 0; j < 4; ++j) { const int col = 4 * lane + 256 * j; const f32x4 sh = *(const f32x4*)(mrow + col), sc = *(const f32x4*)(mrow + 1024 + col), g4 = *(const f32x4*)(gpre + col);
                const f32x4 h = v[j] * rs * g4 * (sc + 1.f) + sh; u32x2 w; w.x = cvt_pk_bf16(h[0], h[1]); w.y = cvt_pk_bf16(h[2], h[3]);
                *(u32x2*)(H + (size_t)r * DM + col) = w; }
        }
    }
}

__device__ __forceinline__ void ext_unit(KA a, int l, int u) {
    const int tid = TIDX(), wave = tid >> 6, lane = tid & 63, fr = lane & 15, fq = lane >> 4;
    const bf16_t* H = (const bf16_t*)(a->ws + WS_H); const bf16_t* We = (const bf16_t*)(a->ws + WS_WEXT) + (size_t)l * 16 * DM; float* EXT = (float*)(a->ws + WS_EXT);
    const int row0 = u * 256 + wave * 32;
    f32x4 acc[2] = {(f32x4){0.f, 0.f, 0.f, 0.f}, (f32x4){0.f, 0.f, 0.f, 0.f}};
    const bf16_t* ap0 = H + (size_t)(row0 + fr) * DM + fq * 8; const bf16_t* ap1 = ap0 + 16 * DM; const bf16_t* bp = We + (size_t)fr * DM + fq * 8;
#pragma unroll 8
    for (int ks = 0; ks < 32; ++ks) { const bf16x8 b = *(const bf16x8*)(bp + ks * 32), a0 = *(const bf16x8*)(ap0 + ks * 32), a1 = *(const bf16x8*)(ap1 + ks * 32);
        acc[0] = __builtin_amdgcn_mfma_f32_16x16x32_bf16(a0, b, acc[0], 0, 0, 0); acc[1] = __builtin_amdgcn_mfma_f32_16x16x32_bf16(a1, b, acc[1], 0, 0, 0); }
#pragma unroll
    for (int mt = 0; mt < 2; ++mt)
#pragma unroll
        for (int r = 0; r < 4; ++r) EXT[(size_t)(row0 + 16 * mt + fq * 4 + r) * 16 + fr] = acc[mt][r];
}
__device__ __forceinline__ void phase_gemm(KA a, int l, bool is_out, LAS unsigned char* lds, int bid, int G) {
    const int M = (is_out && l == DEPTH - 1) ? RL : RT, N = is_out ? DM : PW;
    pg8::Gemm g;
    g.A = is_out ? (const bf16_t*)(a->ws + WS_P) : (const bf16_t*)(a->ws + WS_H);
    g.Bt = is_out ? (const bf16_t*)(a->ws + WS_WOUT) + (size_t)l * DM * DM : (const bf16_t*)(a->ws + WS_WIN) + (size_t)l * PW * DM;
    g.M = M; g.N = N; g.K = DM; g.lda = is_out ? PW : DM; g.seg = is_out ? 1 : 0;
    pg8::StaticOrder S; S.init(M, N, G, bid);
    pg8::EpiBf16 E{is_out ? (bf16_t*)(a->ws + WS_O) : (bf16_t*)(a->ws + WS_P), N};
    pg8::gemm_phase<pg8::EpiBf16>(lds, g, S, E);
    if (!is_out) { const int nwg = (RT / 256) * (PW / 256), first = nwg % G;
        for (int u = (bid - first + G) % G; u < RT / 256; u += G) ext_unit(a, l, u); }
}

__device__ __forceinline__ void phase_sc(KA a, int l, int bid, int G) {
    bf16_t* P = (bf16_t*)(a->ws + WS_P); const float* cw = a->sc_conv_w + (size_t)l * 3 * 256;
    const int nrows = (l == DEPTH - 1) ? RL : RT;
    for (int it = bid * 512 + TIDX(); it < nrows * 32; it += G * 512) {
        const int r = it >> 5, c8 = (it & 31) * 8; const bool is_ctx = r >= RL; const int t = is_ctx ? ((r - RL) & 255) : (r & 2047), len = is_ctx ? TC : TL;
        bf16_t* row = P + (size_t)r * PW;
        float ch[3][8];
#pragma unroll
        for (int d = 0; d < 3; ++d) { const int tt = t + d - 1; const bool ok = tt >= 0 && tt < len;
            u32x4 cv = (u32x4){0, 0, 0, 0}, hv = (u32x4){0, 0, 0, 0};
            if (ok) { cv = *(const u32x4*)(row + (ptrdiff_t)(d - 1) * PW + C_CC + c8); hv = *(const u32x4*)(row + (ptrdiff_t)(d - 1) * PW + C_CH + c8); }
#pragma unroll
            for (int e = 0; e < 4; ++e) { ch[d][2 * e] = bf2f(cv[e] & 0xffffu) * bf2f(hv[e] & 0xffffu); ch[d][2 * e + 1] = bf2f(cv[e] >> 16) * bf2f(hv[e] >> 16); } }
        const u32x4 bv = *(const u32x4*)(row + C_CB + c8), zv = *(const u32x4*)(row + C_CZ + c8);
        float y[8];
#pragma unroll
        for (int e = 0; e < 8; ++e) { const float conv = cw[c8 + e] * ch[0][e] + cw[256 + c8 + e] * ch[1][e] + cw[512 + c8 + e] * ch[2][e];
            const float bb = bf2f((e & 1) ? (bv[e >> 1] >> 16) : (bv[e >> 1] & 0xffffu)), zz = bf2f((e & 1) ? (zv[e >> 1] >> 16) : (zv[e >> 1] & 0xffffu));
            y[e] = bb * conv * silu_f(zz); }
        u32x4 o; o.x = cvt_pk_bf16(y[0], y[1]); o.y = cvt_pk_bf16(y[2], y[3]); o.z = cvt_pk_bf16(y[4], y[5]); o.w = cvt_pk_bf16(y[6], y[7]);
        *(u32x4*)(row + C_CB + c8) = o;
    }
}
__device__ __forceinline__ void phase_sg1(KA a, int l, int bid, int G) {
    const int wave = TIDX() >> 6, lane = TIDX() & 63;
    const bf16_t* P = (const bf16_t*)(a->ws + WS_P); float* SGV = (float*)(a->ws + WS_SGV);
    const int nrows = (l == DEPTH - 1) ? RL : RT;
    for (int r = bid * 8 + wave; r < nrows; r += G * 8) {
        const u32x2 w = *(const u32x2*)(P + (size_t)r * PW + C_SV + 4 * lane);
        f32x4 v = (f32x4){gelu_f(bf2f(w.x & 0xffffu)), gelu_f(bf2f(w.x >> 16)), gelu_f(bf2f(w.y & 0xffffu)), gelu_f(bf2f(w.y >> 16))};
        const float mu = wave_sum(v[0] + v[1] + v[2] + v[3]) * (1.f / 256.f); v = v - mu;
        const float var = wave_sum(v[0] * v[0] + v[1] * v[1] + v[2] * v[2] + v[3] * v[3]) * (1.f / 256.f);
        *(f32x4*)(SGV + (size_t)r * 256 + 4 * lane) = v * rsqrtf(var + EPS);
    }
}
__device__ __forceinline__ void phase_sg2(KA a, int l, LAS unsigned char* lds, int bid, int G) {
    const int tid = TIDX(); bf16_t* P = (bf16_t*)(a->ws + WS_P); const float* SGV = (const float*)(a->ws + WS_SGV);
    LAS float* sv = (LAS float*)lds;
    const int nch = (l == DEPTH - 1) ? 16 : 18;
    for (int it = bid; it < NB * nch; it += G) {
        const int b = it / nch, c = it % nch, base = c < 16 ? b * TL + c * 128 : RL + b * TC + (c - 16) * 128;
        __syncthreads();
        for (int i = tid; i < 128 * 64; i += 512) *(LAS f32x4*)(sv + i * 4) = *(const f32x4*)(SGV + (size_t)base * 256 + i * 4);
        __syncthreads();
        const int ch = tid & 255, h = ch >> 6, i0 = (tid >> 8) * 64;
        const float* W = a->sg_w + ((size_t)l * 4 + h) * 128 * 128; const float* bs = a->sg_b + ((size_t)l * 4 + h) * 128;
        for (int i = i0; i < i0 + 64; ++i) {
            float s = bs[i]; const float* wr = W + (size_t)i * 128;
#pragma unroll 16
            for (int j = 0; j < 128; ++j) s += wr[j] * sv[j * 256 + ch];
            bf16_t* row = P + (size_t)(base + i) * PW;
            const float u = bf2f(row[C_SU + ch]), z = bf2f(row[C_SZ + ch]);
            row[C_SU + ch] = (bf16_t)f2bf(gelu_f(u) * s * silu_f(z));
        }
    }
}
__device__ __forceinline__ void phase_gdn_prep(KA a, int l, int bid, int G) {
    const int wave = TIDX() >> 6, lane = TIDX() & 63;
    const bf16_t* P = (const bf16_t*)(a->ws + WS_P); const float* EXT = (const float*)(a->ws + WS_EXT);
    bf16_t* GQ = (bf16_t*)(a->ws + WS_GQ); bf16_t* GK = (bf16_t*)(a->ws + WS_GK); bf16_t* GV = (bf16_t*)(a->ws + WS_GV); float* GB = (float*)(a->ws + WS_GB);
    const float* cw = a->gdn_conv_w + (size_t)l * 3 * 768;
    for (int it = bid * 8 + wave; it < RT * 4; it += G * 8) {
        const int r = it >> 2, h = it & 3, chn = h * 64 + lane; const bool is_ctx = r >= RL; const int t = is_ctx ? ((r - RL) & 255) : (r & 2047), len = is_ctx ? TC : TL;
        const bf16_t* row = P + (size_t)r * PW;
        float q = 0.f, k = 0.f, v = 0.f;
#pragma unroll
        for (int d = 0; d < 3; ++d) { const int tt = t + d - 1; if (tt >= 0 && tt < len) { const bf16_t* rp = row + (ptrdiff_t)(d - 1) * PW;
            q += cw[d * 768 + chn] * bf2f(rp[C_GQ + chn]); k += cw[d * 768 + 256 + chn] * bf2f(rp[C_GK + chn]); v += cw[d * 768 + 512 + chn] * bf2f(rp[C_GV + chn]); } }
        q = silu_f(q); k = silu_f(k); v = silu_f(v);
        const float qs = rsqrtf(wave_sum(q * q) + EPS), ksn = rsqrtf(wave_sum(k * k) + EPS);
        GQ[(size_t)r * 256 + chn] = (bf16_t)f2bf(q * qs * 0.125f); GK[(size_t)r * 256 + chn] = (bf16_t)f2bf(k * ksn); GV[(size_t)r * 256 + chn] = (bf16_t)f2bf(v);
        if (lane < 4) { const int dir = lane & 1; const float e = EXT[(size_t)r * 16 + (lane >> 1) * 8 + dir * 4 + h]; float o;
            if (lane < 2) o = -__expf(a->gdn_a_log[(l * 2 + dir) * 4 + h]) * softplus_f(e + a->gdn_dt_bias[(l * 2 + dir) * 4 + h]); else o = sigmoid_f(e);
            GB[((size_t)r * 4 + h) * 4 + lane] = o; }
    }
}
__device__ __forceinline__ void phase_gdn_rec(KA a, int l, LAS unsigned char* lds, int bid, int G) {
    const int wave = TIDX() >> 6, lane = TIDX() & 63;
    const bf16_t* GQ = (const bf16_t*)(a->ws + WS_GQ); const bf16_t* GK = (const bf16_t*)(a->ws + WS_GK); const bf16_t* GV = (const bf16_t*)(a->ws + WS_GV); const float* GB = (const float*)(a->ws + WS_GB);
    float* OG = (float*)(a->ws + WS_OG);
    LAS float* qk = (LAS float*)lds + wave * 128;
    for (int ch = bid * 8 + wave; ch < NB * 4 * 2; ch += G * 8) {
        const int b = ch >> 3, h = (ch >> 1) & 3, dir = ch & 1;
        float S[64];
#pragma unroll
        for (int d = 0; d < 64; ++d) S[d] = 0.f;
        float* og = OG + (size_t)dir * RT * 256;
        auto sidx = [&](int i) { return dir == 0 ? i : (i < TC ? TC - 1 - i : (TC + TL - 1) - (i - TC)); };
        int r = seq_row(b, sidx(0));
        float qn = bf2f(GQ[(size_t)r * 256 + h * 64 + lane]), kn = bf2f(GK[(size_t)r * 256 + h * 64 + lane]), vn = bf2f(GV[(size_t)r * 256 + h * 64 + lane]);
        float gn = GB[((size_t)r * 4 + h) * 4 + dir], bn = GB[((size_t)r * 4 + h) * 4 + 2 + dir];
        for (int i = 0; i < TC + TL; ++i) {
            const float q = qn, k = kn, v = vn, g = gn, be = bn; const int rc = r;
            if (i + 1 < TC + TL) { r = seq_row(b, sidx(i + 1));
                qn = bf2f(GQ[(size_t)r * 256 + h * 64 + lane]); kn = bf2f(GK[(size_t)r * 256 + h * 64 + lane]); vn = bf2f(GV[(size_t)r * 256 + h * 64 + lane]);
                gn = GB[((size_t)r * 4 + h) * 4 + dir]; bn = GB[((size_t)r * 4 + h) * 4 + 2 + dir]; }
            qk[lane] = q; qk[64 + lane] = k;
            asm volatile("s_waitcnt lgkmcnt(0)" ::: "memory");
            const float dec = __expf(g); float kS = 0.f;
#pragma unroll
            for (int d4 = 0; d4 < 16; ++d4) { const f32x4 k4 = *(const LAS f32x4*)(qk + 64 + d4 * 4);
#pragma unroll
                for (int e = 0; e < 4; ++e) { S[d4 * 4 + e] *= dec; kS += k4[e] * S[d4 * 4 + e]; } }
            const float delta = be * (v - kS); float o = 0.f;
#pragma unroll
            for (int d4 = 0; d4 < 16; ++d4) { const f32x4 k4 = *(const LAS f32x4*)(qk + 64 + d4 * 4), q4 = *(const LAS f32x4*)(qk + d4 * 4);
#pragma unroll
                for (int e = 0; e < 4; ++e) { S[d4 * 4 + e] += k4[e] * delta; o += q4[e] * S[d4 * 4 + e]; } }
            og[(size_t)rc * 256 + h * 64 + lane] = o;
            asm volatile("s_waitcnt lgkmcnt(0)" ::: "memory");
        }
    }
}
__device__ __forceinline__ void phase_gdn_fin(KA a, int l, int bid, int G) {
    const int wave = TIDX() >> 6, lane = TIDX() & 63;
    bf16_t* P = (bf16_t*)(a->ws + WS_P); const float* OG = (const float*)(a->ws + WS_OG);
    const int nrows = (l == DEPTH - 1) ? RL : RT; const float ng = a->gdn_norm_g[l * 64 + lane];
    for (int it = bid * 8 + wave; it < nrows * 4; it += G * 8) {
        const int r = it >> 2, h = it & 3; const size_t oi = (size_t)r * 256 + h * 64 + lane;
        const float o = OG[oi] + OG[(size_t)RT * 256 + oi];
        const float rs = rsqrtf(wave_sum(o * o) * (1.f / 64.f) + EPS);
        bf16_t* zp = P + (size_t)r * PW + C_GZ + h * 64 + lane;
        *zp = (bf16_t)f2bf(o * rs * ng * silu_f(bf2f(*zp)));
    }
}
__device__ __forceinline__ void phase_ret_rec(KA a, int l, LAS unsigned char* lds, int bid, int G) {
    const int wave = TIDX() >> 6, lane = TIDX() & 63;
    const bf16_t* P = (const bf16_t*)(a->ws + WS_P); float* RO = (float*)(a->ws + WS_OG); const float* rope = (const float*)(a->ws + WS_ROPE);
    LAS float* qk = (LAS float*)lds + wave * 128;
    for (int ch = bid * 8 + wave; ch < NB * 4 * 2; ch += G * 8) {
        const int b = ch >> 3, h = (ch >> 1) & 3, dir = ch & 1;
        const float gamma = 1.f - exp2f(-5.f - (float)h);
        float S[64];
#pragma unroll
        for (int d = 0; d < 64; ++d) S[d] = 0.f;
        float* ro = RO + (size_t)dir * RT * 256;
        auto sidx = [&](int i) { return dir == 0 ? i : (i < TC ? TC - 1 - i : (TC + TL - 1) - (i - TC)); };
        const int f = lane & 15; const bool hi = (lane & 16) != 0, colhalf = lane >= 32;
        int s = sidx(0), r = seq_row(b, s);
        float qn = bf2f(P[(size_t)r * PW + C_RQ + h * 64 + lane]), kn = bf2f(P[(size_t)r * PW + C_RK + h * 64 + lane]), vn = bf2f(P[(size_t)r * PW + C_RV + h * 64 + lane]);
        for (int i = 0; i < TC + TL; ++i) {
            float q = qn, k = kn; const float v = vn; const int rc = r, sc = s;
            if (i + 1 < TC + TL) { s = sidx(i + 1); r = seq_row(b, s);
                qn = bf2f(P[(size_t)r * PW + C_RQ + h * 64 + lane]); kn = bf2f(P[(size_t)r * PW + C_RK + h * 64 + lane]); vn = bf2f(P[(size_t)r * PW + C_RV + h * 64 + lane]); }
            if (sc >= TC) { const int t = sc - TC, pos = colhalf ? (t & 63) : (t >> 6); const float cs = rope[pos * 16 + f], sn = rope[1024 + pos * 16 + f];
                const float qp = __shfl_xor(q, 16), kp = __shfl_xor(k, 16);
                q = hi ? (qp * sn + q * cs) : (q * cs - qp * sn); k = hi ? (kp * sn + k * cs) : (k * cs - kp * sn); }
            k *= 0.125f;
            qk[lane] = q; qk[64 + lane] = k;
            asm volatile("s_waitcnt lgkmcnt(0)" ::: "memory");
            float o = 0.f;
#pragma unroll
            for (int d4 = 0; d4 < 16; ++d4) { const f32x4 k4 = *(const LAS f32x4*)(qk + 64 + d4 * 4), q4 = *(const LAS f32x4*)(qk + d4 * 4);
#pragma unroll
                for (int e = 0; e < 4; ++e) { S[d4 * 4 + e] = gamma * S[d4 * 4 + e] + k4[e] * v; o += q4[e] * S[d4 * 4 + e]; } }
            ro[(size_t)rc * 256 + h * 64 + lane] = o;
            asm volatile("s_waitcnt lgkmcnt(0)" ::: "memory");
        }
    }
}
__device__ __forceinline__ void phase_ret_fin(KA a, int l, int bid, int G) {
    const int wave = TIDX() >> 6, lane = TIDX() & 63;
    bf16_t* P = (bf16_t*)(a->ws + WS_P); const float* RO = (const float*)(a->ws + WS_OG);
    const int nrows = (l == DEPTH - 1) ? RL : RT;
    for (int it = bid * 8 + wave; it < nrows * 4; it += G * 8) {
        const int r = it >> 2, h = it & 3; const size_t oi = (size_t)r * 256 + h * 64 + lane;
        float o = RO[oi] + RO[(size_t)RT * 256 + oi];
        const float mu = wave_sum(o) * (1.f / 64.f); o -= mu;
        const float rs = rsqrtf(wave_sum(o * o) * (1.f / 64.f) + EPS);
        const float z = bf2f(P[(size_t)r * PW + C_RZ + h * 64 + lane]);
        P[(size_t)r * PW + C_RQ + h * 64 + lane] = (bf16_t)f2bf(o * rs * a->ret_norm_g[l * 256 + h * 64 + lane] * silu_f(z));
    }
}

__device__ __forceinline__ void unpack8(const u32x4 w, float* o) {
#pragma unroll
    for (int e = 0; e < 4; ++e) { o[2 * e] = bf2f(w[e] & 0xffffu); o[2 * e + 1] = bf2f(w[e] >> 16); }
}
__device__ __forceinline__ void rot8(const bf16_t* hrow, int g, bool rot, int t, const float* rope, float* out) {
    unpack8(*(const u32x4*)(hrow + 8 * g), out);
    if (rot) { float p[8]; unpack8(*(const u32x4*)(hrow + 8 * (g ^ 2)), p);
        const int pos = (g >> 2) ? (t & 63) : (t >> 6), f0 = 8 * (g & 1); const bool hi = (g & 2) != 0;
        const f32x4 c0 = *(const f32x4*)(rope + pos * 16 + f0), c1 = *(const f32x4*)(rope + pos * 16 + f0 + 4), s0 = *(const f32x4*)(rope + 1024 + pos * 16 + f0), s1 = *(const f32x4*)(rope + 1024 + pos * 16 + f0 + 4);
#pragma unroll
        for (int j = 0; j < 8; ++j) { const float cs = j < 4 ? c0[j & 3] : c1[j & 3], sn = j < 4 ? s0[j & 3] : s1[j & 3]; out[j] = hi ? (p[j] * sn + out[j] * cs) : (out[j] * cs - p[j] * sn); } }
}
__device__ __forceinline__ int ret_row0(int b, int c) { return c < 2 ? RL + b * TC + c * 128 : b * TL + (c - 2) * 128; }
constexpr int TS = 272, RS = 144;

__device__ __forceinline__ void phase_ret_kv(KA a, int l, LAS unsigned char* lds, int bid, int G) {
    const int tid = TIDX(), wave = tid >> 6, lane = tid & 63, fr = lane & 15, fq = lane >> 4;
    const bf16_t* P = (const bf16_t*)(a->ws + WS_P); const float* rope = (const float*)(a->ws + WS_ROPE); bf16_t* KV = (bf16_t*)(a->ws + WS_KV);
    LAS unsigned char* kTf = lds; LAS unsigned char* kTb = lds + 64 * TS; LAS unsigned char* vT = lds + 128 * TS;
    for (int u = bid; u < NB * 18 * 4; u += G) {
        const int h = u & 3, c = (u >> 2) % 18, b = (u >> 2) / 18, row0 = ret_row0(b, c); const bool rot = c >= 2;
        const float lg = log2f(1.f - exp2f(-5.f - (float)h));
        __syncthreads();
        { const int g = wave, pp = lane, p0 = 2 * pp;
          float k0[8], k1[8], v0[8], v1[8];
          const bf16_t* r0 = P + (size_t)(row0 + p0) * PW + h * 64; const bf16_t* r1 = r0 + PW;
          rot8(r0 + C_RK, g, rot, (c - 2) * 128 + p0, rope, k0); rot8(r1 + C_RK, g, rot, (c - 2) * 128 + p0 + 1, rope, k1);
          unpack8(*(const u32x4*)(r0 + C_RV + 8 * g), v0); unpack8(*(const u32x4*)(r1 + C_RV + 8 * g), v1);
          const float wf0 = 0.125f * exp2f(lg * (float)(127 - p0)), wf1 = 0.125f * exp2f(lg * (float)(126 - p0)), wb0 = 0.125f * exp2f(lg * (float)p0), wb1 = 0.125f * exp2f(lg * (float)(p0 + 1));
#pragma unroll
          for (int j = 0; j < 8; ++j) { const int d = 8 * g + j;
              *(LAS unsigned*)(kTf + d * TS + pp * 4) = cvt_pk_bf16(k0[j] * wf0, k1[j] * wf1);
              *(LAS unsigned*)(kTb + d * TS + pp * 4) = cvt_pk_bf16(k0[j] * wb0, k1[j] * wb1);
              *(LAS unsigned*)(vT + d * TS + pp * 4) = cvt_pk_bf16(v0[j], v1[j]); } }
        __syncthreads();
        { const int dir = wave >> 2, mt = wave & 3; LAS unsigned char* kT = dir ? kTb : kTf;
          bf16x8 af[4];
#pragma unroll
          for (int ks = 0; ks < 4; ++ks) af[ks] = *(const LAS bf16x8*)(kT + (16 * mt + fr) * TS + (ks * 32 + fq * 8) * 2);
          bf16_t* dst = KV + ((size_t)u * 2 + dir) * 4096;
#pragma unroll
          for (int nt = 0; nt < 4; ++nt) { f32x4 acc = (f32x4){0.f, 0.f, 0.f, 0.f};
#pragma unroll
              for (int ks = 0; ks < 4; ++ks) { const bf16x8 bfr = *(const LAS bf16x8*)(vT + (16 * nt + fr) * TS + (ks * 32 + fq * 8) * 2); acc = __builtin_amdgcn_mfma_f32_16x16x32_bf16(af[ks], bfr, acc, 0, 0, 0); }
              u32x2 w; w.x = cvt_pk_bf16(acc[0], acc[1]); w.y = cvt_pk_bf16(acc[2], acc[3]);
              *(u32x2*)(dst + (16 * nt + fr) * 64 + 16 * mt + fq * 4) = w; } }
    }
}
__device__ __forceinline__ void phase_ret_out(KA a, int l, LAS unsigned char* lds, int bid, int G) {
    const int tid = TIDX(), wave = tid >> 6, lane = tid & 63, fr = lane & 15, fq = lane >> 4;
    bf16_t* P = (bf16_t*)(a->ws + WS_P); const float* rope = (const float*)(a->ws + WS_ROPE); const bf16_t* KV = (const bf16_t*)(a->ws + WS_KV);
    LAS unsigned char* qL = lds; LAS unsigned char* kL = lds + 128 * RS; LAS unsigned char* vT = lds + 256 * RS; LAS unsigned char* sF = vT + 64 * TS; LAS unsigned char* sB = sF + 64 * RS;
    LAS float* oL = (LAS float*)(sB + 64 * RS) + wave * (16 * 68);
    const int c_lo = (l == DEPTH - 1) ? 2 : 0, ncu = 18 - c_lo;
    for (int u = bid; u < NB * ncu * 4; u += G) {
        const int h = u & 3, c = c_lo + (u >> 2) % ncu, b = (u >> 2) / ncu, row0 = ret_row0(b, c); const bool rot = c >= 2;
        const float lg = log2f(1.f - exp2f(-5.f - (float)h));
        __syncthreads();
#pragma unroll
        for (int it = 0; it < 2; ++it) { const int item = tid + it * 512, p = item >> 3, g = item & 7; float q8[8], k8[8];
            const bf16_t* rp = P + (size_t)(row0 + p) * PW + h * 64;
            rot8(rp + C_RQ, g, rot, (c - 2) * 128 + p, rope, q8); rot8(rp + C_RK, g, rot, (c - 2) * 128 + p, rope, k8);
            u32x4 w; w.x = cvt_pk_bf16(q8[0], q8[1]); w.y = cvt_pk_bf16(q8[2], q8[3]); w.z = cvt_pk_bf16(q8[4], q8[5]); w.w = cvt_pk_bf16(q8[6], q8[7]);
            *(LAS u32x4*)(qL + p * RS + g * 16) = w;
            w.x = cvt_pk_bf16(k8[0] * 0.125f, k8[1] * 0.125f); w.y = cvt_pk_bf16(k8[2] * 0.125f, k8[3] * 0.125f); w.z = cvt_pk_bf16(k8[4] * 0.125f, k8[5] * 0.125f); w.w = cvt_pk_bf16(k8[6] * 0.125f, k8[7] * 0.125f);
            *(LAS u32x4*)(kL + p * RS + g * 16) = w; }
        { const int g = wave, pp = lane; const bf16_t* r0 = P + (size_t)(row0 + 2 * pp) * PW + C_RV + h * 64 + 8 * g;
          const u32x4 w0 = *(const u32x4*)r0, w1 = *(const u32x4*)(r0 + PW);
#pragma unroll
          for (int j = 0; j < 8; ++j) { const unsigned lo = (j & 1) ? (w0[j >> 1] >> 16) : (w0[j >> 1] & 0xffffu), hi2 = (j & 1) ? (w1[j >> 1] >> 16) : (w1[j >> 1] & 0xffffu);
              *(LAS unsigned*)(vT + (8 * g + j) * TS + pp * 4) = lo | (hi2 << 16); } }
        { const int e = tid >> 3, d0 = (tid & 7) * 8; const float lc = lg * 128.f;
          float sf[8], sb[8];
#pragma unroll
          for (int j = 0; j < 8; ++j) { sf[j] = 0.f; sb[j] = 0.f; }
          const int obc = c < 2 ? 1 - c : 19 - c;
          for (int j = 0; j < EXP_NJ; ++j) { const int obj = j < 2 ? 1 - j : 19 - j; const bf16_t* kv = KV + ((size_t)((b * 18 + j) * 4 + h) * 2) * 4096 + e * 64 + d0;
              if (j < c) { float t8[8]; unpack8(*(const u32x4*)kv, t8); const float wgt = exp2f(lc * (float)(c - 1 - j));
#pragma unroll
                  for (int x = 0; x < 8; ++x) sf[x] += wgt * t8[x]; }
              if (obj < obc) { float t8[8]; unpack8(*(const u32x4*)(kv + 4096), t8); const float wgt = exp2f(lc * (float)(obc - 1 - obj));
#pragma unroll
                  for (int x = 0; x < 8; ++x) sb[x] += wgt * t8[x]; } }
          u32x4 w; w.x = cvt_pk_bf16(sf[0], sf[1]); w.y = cvt_pk_bf16(sf[2], sf[3]); w.z = cvt_pk_bf16(sf[4], sf[5]); w.w = cvt_pk_bf16(sf[6], sf[7]);
          *(LAS u32x4*)(sF + e * RS + d0 * 2) = w;
          w.x = cvt_pk_bf16(sb[0], sb[1]); w.y = cvt_pk_bf16(sb[2], sb[3]); w.z = cvt_pk_bf16(sb[4], sb[5]); w.w = cvt_pk_bf16(sb[6], sb[7]);
          *(LAS u32x4*)(sB + e * RS + d0 * 2) = w; }
        __syncthreads();
        const int i0 = 16 * wave;
        bf16x8 qf[2];
#pragma unroll
        for (int ks = 0; ks < 2; ++ks) qf[ks] = *(const LAS bf16x8*)(qL + (i0 + fr) * RS + (ks * 32 + fq * 8) * 2);
        bf16x8 pf[4];
#pragma unroll
        for (int t = 0; t < 4; ++t) { f32x4 s2[2];
#pragma unroll
            for (int hh = 0; hh < 2; ++hh) { const int jt = 2 * t + hh; f32x4 acc = (f32x4){0.f, 0.f, 0.f, 0.f};
#pragma unroll
                for (int ks = 0; ks < 2; ++ks) { const bf16x8 kf = *(const LAS bf16x8*)(kL + (16 * jt + fr) * RS + (ks * 32 + fq * 8) * 2); acc = __builtin_amdgcn_mfma_f32_16x16x32_bf16(kf, qf[ks], acc, 0, 0, 0); }
#pragma unroll
                for (int r = 0; r < 4; ++r) { const int jj = 16 * jt + 4 * fq + r, ii = i0 + fr, df = ii > jj ? ii - jj : jj - ii; acc[r] *= exp2f(lg * (float)df) * (df == 0 ? 2.f : 1.f); }
                s2[hh] = acc; }
            u32x4 w; w.x = cvt_pk_bf16(s2[0][0], s2[0][1]); w.y = cvt_pk_bf16(s2[0][2], s2[0][3]); w.z = cvt_pk_bf16(s2[1][0], s2[1][1]); w.w = cvt_pk_bf16(s2[1][2], s2[1][3]);
            pf[t] = __builtin_bit_cast(bf16x8, w); }
        float dq[4], db[4];
#pragma unroll
        for (int r = 0; r < 4; ++r) { const int pi = i0 + 4 * fq + r; dq[r] = exp2f(lg * (float)(pi + 1)); db[r] = exp2f(lg * (float)(128 - pi)); }
        f32x4 o[4]; float sum[4] = {0.f, 0.f, 0.f, 0.f};
#pragma unroll
        for (int nt = 0; nt < 4; ++nt) { f32x4 acc = (f32x4){0.f, 0.f, 0.f, 0.f}, af = acc, ab = acc;
#pragma unroll
            for (int t = 0; t < 4; ++t) { const LAS unsigned char* vp = vT + (16 * nt + fr) * TS + (32 * t + 4 * fq) * 2;
                const u32x2 lo = *(const LAS u32x2*)vp, hi2 = *(const LAS u32x2*)(vp + 32); const u32x4 w = (u32x4){lo.x, lo.y, hi2.x, hi2.y};
                acc = __builtin_amdgcn_mfma_f32_16x16x32_bf16(pf[t], __builtin_bit_cast(bf16x8, w), acc, 0, 0, 0); }
#pragma unroll
            for (int ks = 0; ks < 2; ++ks) { const bf16x8 s1 = *(const LAS bf16x8*)(sF + (16 * nt + fr) * RS + (ks * 32 + fq * 8) * 2), s2 = *(const LAS bf16x8*)(sB + (16 * nt + fr) * RS + (ks * 32 + fq * 8) * 2);
                af = __builtin_amdgcn_mfma_f32_16x16x32_bf16(qf[ks], s1, af, 0, 0, 0); ab = __builtin_amdgcn_mfma_f32_16x16x32_bf16(qf[ks], s2, ab, 0, 0, 0); }
#pragma unroll
            for (int r = 0; r < 4; ++r) { acc[r] += af[r] * dq[r] + ab[r] * db[r]; sum[r] += acc[r]; }
            o[nt] = acc; }
        float mu[4], rs[4];
#pragma unroll
        for (int r = 0; r < 4; ++r) { float sv = sum[r]; sv += __shfl_xor(sv, 1); sv += __shfl_xor(sv, 2); sv += __shfl_xor(sv, 4); sv += __shfl_xor(sv, 8); mu[r] = sv * (1.f / 64.f);
            float q2 = 0.f;
#pragma unroll
            for (int nt = 0; nt < 4; ++nt) { const float dd = o[nt][r] - mu[r]; q2 += dd * dd; }
            q2 += __shfl_xor(q2, 1); q2 += __shfl_xor(q2, 2); q2 += __shfl_xor(q2, 4); q2 += __shfl_xor(q2, 8); rs[r] = rsqrtf(q2 * (1.f / 64.f) + EPS); }
#pragma unroll
        for (int nt = 0; nt < 4; ++nt)
#pragma unroll
            for (int r = 0; r < 4; ++r) oL[(4 * fq + r) * 68 + 16 * nt + fr] = (o[nt][r] - mu[r]) * rs[r];
        __syncthreads();
#pragma unroll
        for (int it = 0; it < 2; ++it) { const int item = lane + 64 * it, rr = item >> 3, g = item & 7;
            const f32x4 x0 = *(const LAS f32x4*)(oL + rr * 68 + 8 * g), x1 = *(const LAS f32x4*)(oL + rr * 68 + 8 * g + 4);
            bf16_t* rp = P + (size_t)(row0 + i0 + rr) * PW + h * 64 + 8 * g; float z8[8]; unpack8(*(const u32x4*)(rp + C_RZ), z8);
            const float* ng = a->ret_norm_g + l * 256 + h * 64 + 8 * g; const f32x4 g0 = *(const f32x4*)ng, g1 = *(const f32x4*)(ng + 4);
            float y[8];
#pragma unroll
            for (int j = 0; j < 8; ++j) y[j] = (j < 4 ? x0[j & 3] * g0[j & 3] : x1[j & 3] * g1[j & 3]) * silu_f(z8[j]);
            u32x4 w; w.x = cvt_pk_bf16(y[0], y[1]); w.y = cvt_pk_bf16(y[2], y[3]); w.z = cvt_pk_bf16(y[4], y[5]); w.w = cvt_pk_bf16(y[6], y[7]);
#if EXP_NOINPLACE
            *(u32x4*)((bf16_t*)(a->ws + WS_OG) + (size_t)(row0 + i0 + rr) * 256 + h * 64 + 8 * g) = w; }
#else
            *(u32x4*)(rp + C_RQ) = w; }
#endif
    }
}
__device__ __forceinline__ void phase_ret_copy(KA a, int l, int bid, int G) {
    bf16_t* P = (bf16_t*)(a->ws + WS_P); const bf16_t* Y = (const bf16_t*)(a->ws + WS_OG);
    const int nrows = (l == DEPTH - 1) ? RL : RT;
    for (int it = bid * 512 + TIDX(); it < nrows * 32; it += G * 512) { const int r = it >> 5, c8 = (it & 31) * 8;
        *(u32x4*)(P + (size_t)r * PW + C_RQ + c8) = *(const u32x4*)(Y + (size_t)r * 256 + c8); }
}

constexpr size_t WS_QN = WS_X, WS_KN = WS_X + 18 * MiB, WS_KNT = WS_X + 36 * MiB, WS_WN = WS_X + 54 * MiB, WS_UT = WS_X + 90 * MiB, WS_SOLD0 = WS_X + 126 * MiB,
                 WS_SOLD1 = 492 * MiB, WS_GC = 510 * MiB, WS_END2 = 512 * MiB;
__device__ __forceinline__ int gdn_row0(int b, int c) { return c < 4 ? RL + b * TC + c * 64 : b * TL + (c - 4) * 64; }
__device__ __forceinline__ u32x4 pack8(const float* v) { u32x4 w; w.x = cvt_pk_bf16(v[0], v[1]); w.y = cvt_pk_bf16(v[2], v[3]); w.z = cvt_pk_bf16(v[4], v[5]); w.w = cvt_pk_bf16(v[6], v[7]); return w; }

template <int DIR>
__device__ __forceinline__ void gdn_solve(int tid, int gub, LAS unsigned char* knL, LAS float* vL, LAS float* Lm, LAS float* btL, LAS float* egL, bf16_t* UT, bf16_t* WN) {
    const int hd = tid >> 7, hh = hd >> 1, col = tid & 127; const bool is_u = col < 64; const int cc = col & 63;
    float x[64];
#pragma unroll
    for (int p = 0; p < 64; ++p) x[p] = 0.f;
    const LAS float* Lb = Lm + hd * 4096; const LAS float* vb = vL + hh * 4096 + cc; const LAS unsigned char* kb = knL + hh * 64 * 144 + cc * 2; const LAS float* bb = btL + hd * 64; const LAS float* eb = egL + hd * 64;
#pragma unroll
    for (int p = 0; p < 64; ++p) { constexpr int dummy = 0; const int i = DIR ? 63 - p : p; (void)dummy;
        const float bt = bb[i], vv = vb[i * 64], kk = bf2f(*(const LAS bf16_t*)(kb + i * 144)) * eb[i];
        float acc = (is_u ? vv : kk) * bt;
#pragma unroll
        for (int q4 = 0; q4 < (p + 3) / 4; ++q4) { const f32x4 l4 = *(const LAS f32x4*)(Lb + p * 64 + 4 * q4);
            acc -= l4[0] * x[4 * q4] + l4[1] * x[4 * q4 + 1] + l4[2] * x[4 * q4 + 2] + l4[3] * x[4 * q4 + 3]; }
        x[p] = acc; }
    const size_t gu2 = (size_t)(gub + hh) * 2 + DIR;
    if (is_u) { bf16_t* dst = UT + (gu2 * 64 + cc) * 64;
#pragma unroll
        for (int i8 = 0; i8 < 8; ++i8) { float t8[8];
#pragma unroll
            for (int e = 0; e < 8; ++e) { const int i = 8 * i8 + e; t8[e] = DIR ? x[63 - i] : x[i]; }
            *(u32x4*)(dst + 8 * i8) = pack8(t8); } }
    else { bf16_t* dst = WN + gu2 * 4096 + cc;
#pragma unroll
        for (int i = 0; i < 64; ++i) dst[i * 64] = (bf16_t)f2bf(-(DIR ? x[63 - i] : x[i])); }
}
__device__ __forceinline__ void phase_gdn_prep2(KA a, int l, LAS unsigned char* lds, int bid, int G) {
    const int tid = TIDX(), wave = tid >> 6, lane = tid & 63, fr = lane & 15, fq = lane >> 4;
    unsigned char* ws = a->ws; const bf16_t* P = (const bf16_t*)(ws + WS_P); const float* EXT = (const float*)(ws + WS_EXT);
    bf16_t* QN = (bf16_t*)(ws + WS_QN); bf16_t* KN = (bf16_t*)(ws + WS_KN); bf16_t* KNT = (bf16_t*)(ws + WS_KNT); bf16_t* WN = (bf16_t*)(ws + WS_WN); bf16_t* UT = (bf16_t*)(ws + WS_UT); float* GC = (float*)(ws + WS_GC);
    LAS unsigned char* knL = lds;
    LAS float* vL = (LAS float*)(lds + 18432);
    LAS float* Lm = (LAS float*)(lds + 51200);
    LAS float* gcL = (LAS float*)(lds + 116736); LAS float* btL = gcL + 256; LAS float* egL = gcL + 512;
    const float* cw = a->gdn_conv_w + (size_t)l * 3 * 768;
    for (int u = bid; u < NB * 36 * 2; u += G) {
        const int hp = u & 1, c = (u >> 1) % 36, b = (u >> 1) / 36, row0 = gdn_row0(b, c); const bool is_ctx = c < 4;
        const int t0 = is_ctx ? c * 64 : (c - 4) * 64, len = is_ctx ? TC : TL; const int gub = ((b * 36 + c) * 4 + hp * 2);
        __syncthreads();
        {
            const int g = tid & 7, hh = (tid >> 3) & 1, h = hp * 2 + hh, chq = h * 64 + 8 * g; const int gu = gub + hh;
            float wq[3][8], wk[3][8], wv[3][8];
#pragma unroll
            for (int tap = 0; tap < 3; ++tap) { const float* cp = cw + tap * 768 + chq;
                const f32x4 a0 = *(const f32x4*)cp, a1 = *(const f32x4*)(cp + 4), b0 = *(const f32x4*)(cp + 256), b1 = *(const f32x4*)(cp + 260), c0 = *(const f32x4*)(cp + 512), c1 = *(const f32x4*)(cp + 516);
#pragma unroll
                for (int j = 0; j < 4; ++j) { wq[tap][j] = a0[j]; wq[tap][4 + j] = a1[j]; wk[tap][j] = b0[j]; wk[tap][4 + j] = b1[j]; wv[tap][j] = c0[j]; wv[tap][4 + j] = c1[j]; } }
#pragma unroll
            for (int it = 0; it < 2; ++it) { const int i = (tid >> 4) + 32 * it, t = t0 + i; const bf16_t* rowp = P + (size_t)(row0 + i) * PW + chq;
                float q8[8], k8[8], v8[8];
#pragma unroll
                for (int j = 0; j < 8; ++j) { q8[j] = 0.f; k8[j] = 0.f; v8[j] = 0.f; }
#pragma unroll
                for (int tap = 0; tap < 3; ++tap) { const int tt = t + tap - 1; if (tt >= 0 && tt < len) { const bf16_t* rp = rowp + (ptrdiff_t)(tap - 1) * PW; float x8[8];
                    unpack8(*(const u32x4*)(rp + C_GQ), x8);
#pragma unroll
                    for (int j = 0; j < 8; ++j) q8[j] += wq[tap][j] * x8[j];
                    unpack8(*(const u32x4*)(rp + C_GK), x8);
#pragma unroll
                    for (int j = 0; j < 8; ++j) k8[j] += wk[tap][j] * x8[j];
                    unpack8(*(const u32x4*)(rp + C_GV), x8);
#pragma unroll
                    for (int j = 0; j < 8; ++j) v8[j] += wv[tap][j] * x8[j]; } }
                float sq = 0.f, sk = 0.f;
#pragma unroll
                for (int j = 0; j < 8; ++j) { q8[j] = silu_f(q8[j]); k8[j] = silu_f(k8[j]); v8[j] = silu_f(v8[j]); sq += q8[j] * q8[j]; sk += k8[j] * k8[j]; }
                sq += __shfl_xor(sq, 1); sq += __shfl_xor(sq, 2); sq += __shfl_xor(sq, 4); sk += __shfl_xor(sk, 1); sk += __shfl_xor(sk, 2); sk += __shfl_xor(sk, 4);
                const float rq = rsqrtf(sq + EPS) * 0.125f, rk = rsqrtf(sk + EPS);
#pragma unroll
                for (int j = 0; j < 8; ++j) { q8[j] *= rq; k8[j] *= rk; }
                *(u32x4*)(QN + ((size_t)gu * 64 + i) * 64 + 8 * g) = pack8(q8);
                const u32x4 kw = pack8(k8);
                *(u32x4*)(KN + ((size_t)gu * 64 + i) * 64 + 8 * g) = kw;
                *(LAS u32x4*)(knL + (hh * 64 + i) * 144 + g * 16) = kw;
                *(LAS f32x4*)(vL + (hh * 64 + i) * 64 + 8 * g) = (f32x4){v8[0], v8[1], v8[2], v8[3]}; *(LAS f32x4*)(vL + (hh * 64 + i) * 64 + 8 * g + 4) = (f32x4){v8[4], v8[5], v8[6], v8[7]}; }
        }
        if (wave < 4) {
            const int hh = wave >> 1, dir = wave & 1, h = hp * 2 + hh, i = lane; const size_t row = (size_t)(row0 + i);
            const float av = EXT[row * 16 + dir * 4 + h], bv = EXT[row * 16 + 8 + dir * 4 + h];
            float gcum = -__expf(a->gdn_a_log[(l * 2 + dir) * 4 + h]) * softplus_f(av + a->gdn_dt_bias[(l * 2 + dir) * 4 + h]);
#pragma unroll
            for (int o = 1; o < 64; o <<= 1) { const float up = __shfl_up(gcum, o), dn = __shfl_down(gcum, o); if (dir == 0) { if (lane >= o) gcum += up; } else { if (lane + o < 64) gcum += dn; } }
            gcL[wave * 64 + i] = gcum; btL[wave * 64 + i] = sigmoid_f(bv); egL[wave * 64 + i] = __expf(gcum);
            GC[((size_t)(gub + hh) * 2 + dir) * 64 + i] = gcum;
        }
        __syncthreads();
        {
            const int hh = wave >> 2, it_ = wave & 3; LAS unsigned char* kb = knL + hh * 64 * 144;
            bf16x8 af[2];
#pragma unroll
            for (int ks = 0; ks < 2; ++ks) af[ks] = *(const LAS bf16x8*)(kb + (16 * it_ + fr) * 144 + (ks * 32 + fq * 8) * 2);
#pragma unroll
            for (int jt = 0; jt < 4; ++jt) { f32x4 acc = (f32x4){0.f, 0.f, 0.f, 0.f};
#pragma unroll
                for (int ks = 0; ks < 2; ++ks) { const bf16x8 bfr = *(const LAS bf16x8*)(kb + (16 * jt + fr) * 144 + (ks * 32 + fq * 8) * 2); acc = __builtin_amdgcn_mfma_f32_16x16x32_bf16(af[ks], bfr, acc, 0, 0, 0); }
                const int j = 16 * jt + fr;
#pragma unroll
                for (int dir = 0; dir < 2; ++dir) { const int hd = hh * 2 + dir; const float gj = gcL[hd * 64 + j];
#pragma unroll
                    for (int r = 0; r < 4; ++r) { const int i = 16 * it_ + 4 * fq + r; const bool valid = dir ? (i < j) : (i > j);
                        const float val = valid ? btL[hd * 64 + i] * acc[r] * __expf(gcL[hd * 64 + i] - gj) : 0.f;
                        const int p = dir ? 63 - i : i, q = dir ? 63 - j : j; Lm[(hd * 64 + p) * 64 + q] = val; } } }
#pragma unroll
            for (int it2 = 0; it2 < 2; ++it2) { const int item = tid + 512 * it2, hh2 = item >> 9, d = (item >> 3) & 63, tg = item & 7; float t8[8];
#pragma unroll
                for (int x = 0; x < 8; ++x) t8[x] = bf2f(*(const LAS bf16_t*)(knL + (hh2 * 64 + 8 * tg + x) * 144 + d * 2));
                *(u32x4*)(KNT + ((size_t)(gub + hh2) * 64 + d) * 64 + 8 * tg) = pack8(t8); }
        }
        __syncthreads();
        {
            const int w8 = __builtin_amdgcn_readfirstlane(tid >> 6);
            if ((w8 >> 1) & 1) gdn_solve<1>(tid, gub, knL, vL, Lm, btL, egL, UT, WN); else gdn_solve<0>(tid, gub, knL, vL, Lm, btL, egL, UT, WN);
        }
    }
}
__device__ __forceinline__ void phase_gdn_chain(KA a, int l, int bid, int G) {
    const int tid = TIDX(), wave = tid >> 6, lane = tid & 63, fr = lane & 15, fq = lane >> 4;
    unsigned char* ws = a->ws; const bf16_t* KNT = (const bf16_t*)(ws + WS_KNT); const bf16_t* WN = (const bf16_t*)(ws + WS_WN); bf16_t* UT = (bf16_t*)(ws + WS_UT); const float* GC = (const float*)(ws + WS_GC);
    if (wave >= 4) return;
    for (int ch = bid; ch < NB * 8; ch += G) {
        const int b = ch >> 3, h = (ch >> 1) & 3, dir = ch & 1, n0 = 16 * wave;
        bf16_t* SOLD = (bf16_t*)(ws + (dir ? WS_SOLD1 : WS_SOLD0));
        f32x4 Sc[4]; u32x4 Sb[2];
#pragma unroll
        for (int m = 0; m < 4; ++m) Sc[m] = (f32x4){0.f, 0.f, 0.f, 0.f};
        Sb[0] = (u32x4){0, 0, 0, 0}; Sb[1] = Sb[0];
        u32x4 wn[4][2], kt[4][2]; u32x2 uu[4];
        auto chunk_of = [&](int k) { return dir == 0 ? k : (k < 4 ? 3 - k : 39 - k); };
        auto load_ops = [&](int k, u32x4 (&wn_)[4][2], u32x4 (&kt_)[4][2], u32x2 (&uu_)[4]) {
            const int c = chunk_of(k); const size_t gu = (size_t)((b * 36 + c) * 4 + h), gu2 = gu * 2 + dir;
            const bf16_t* wp = WN + gu2 * 4096 + (size_t)fr * 64 + 4 * fq; const bf16_t* kp = KNT + gu * 4096 + (size_t)fr * 64 + 4 * fq; const bf16_t* up = UT + gu2 * 4096 + (size_t)(n0 + fr) * 64 + 4 * fq;
#pragma unroll
            for (int m = 0; m < 4; ++m) {
#pragma unroll
                for (int ks = 0; ks < 2; ++ks) { const u32x2 w0 = *(const u32x2*)(wp + m * 1024 + ks * 32), w1 = *(const u32x2*)(wp + m * 1024 + ks * 32 + 16); wn_[m][ks] = (u32x4){w0.x, w0.y, w1.x, w1.y};
                    const u32x2 k0 = *(const u32x2*)(kp + m * 1024 + ks * 32), k1 = *(const u32x2*)(kp + m * 1024 + ks * 32 + 16); kt_[m][ks] = (u32x4){k0.x, k0.y, k1.x, k1.y}; }
                uu_[m] = *(const u32x2*)(up + m * 16); } };
        load_ops(0, wn, kt, uu);
        for (int k = 0; k < 36; ++k) {
            const int c = chunk_of(k); const size_t gu = (size_t)((b * 36 + c) * 4 + h), gu2 = gu * 2 + dir;
            const float* gcp = GC + gu2 * 64; f32x4 gcv[2][2];
#pragma unroll
            for (int ks = 0; ks < 2; ++ks) { gcv[ks][0] = *(const f32x4*)(gcp + 32 * ks + 4 * fq); gcv[ks][1] = *(const f32x4*)(gcp + 32 * ks + 16 + 4 * fq); }
            const float glast = gcp[dir ? 0 : 63];
            u32x4 wn2[4][2], kt2[4][2]; u32x2 uu2[4];
            if (k + 1 < 36) load_ops(k + 1, wn2, kt2, uu2);
            f32x4 vn[4];
#pragma unroll
            for (int m = 0; m < 4; ++m) { f32x4 acc = (f32x4){bf2f(uu[m].x & 0xffffu), bf2f(uu[m].x >> 16), bf2f(uu[m].y & 0xffffu), bf2f(uu[m].y >> 16)};
#pragma unroll
                for (int ks = 0; ks < 2; ++ks) acc = __builtin_amdgcn_mfma_f32_16x16x32_bf16(__builtin_bit_cast(bf16x8, wn[m][ks]), __builtin_bit_cast(bf16x8, Sb[ks]), acc, 0, 0, 0);
                vn[m] = acc; }
            bf16_t* vdst = UT + gu2 * 4096 + (size_t)(n0 + fr) * 64 + 4 * fq; bf16_t* sdst = SOLD + gu * 4096 + (size_t)(n0 + fr) * 64 + 4 * fq;
#pragma unroll
            for (int m = 0; m < 4; ++m) { u32x2 w; w.x = cvt_pk_bf16(vn[m][0], vn[m][1]); w.y = cvt_pk_bf16(vn[m][2], vn[m][3]); *(u32x2*)(vdst + m * 16) = w;
                u32x2 s2; s2.x = (m & 1) ? Sb[m >> 1].z : Sb[m >> 1].x; s2.y = (m & 1) ? Sb[m >> 1].w : Sb[m >> 1].y; *(u32x2*)(sdst + m * 16) = s2; }
            u32x4 Vb[2];
#pragma unroll
            for (int ks = 0; ks < 2; ++ks) { f32x4 e0, e1;
#pragma unroll
                for (int r = 0; r < 4; ++r) { e0[r] = vn[2 * ks][r] * __expf(glast - gcv[ks][0][r]); e1[r] = vn[2 * ks + 1][r] * __expf(glast - gcv[ks][1][r]); }
                Vb[ks] = (u32x4){cvt_pk_bf16(e0[0], e0[1]), cvt_pk_bf16(e0[2], e0[3]), cvt_pk_bf16(e1[0], e1[1]), cvt_pk_bf16(e1[2], e1[3])}; }
            const float cd = __expf(glast);
#pragma unroll
            for (int m = 0; m < 4; ++m) { f32x4 acc = Sc[m] * cd;
#pragma unroll
                for (int ks = 0; ks < 2; ++ks) acc = __builtin_amdgcn_mfma_f32_16x16x32_bf16(__builtin_bit_cast(bf16x8, kt[m][ks]), __builtin_bit_cast(bf16x8, Vb[ks]), acc, 0, 0, 0);
                Sc[m] = acc; }
#pragma unroll
            for (int ks = 0; ks < 2; ++ks) Sb[ks] = (u32x4){cvt_pk_bf16(Sc[2 * ks][0], Sc[2 * ks][1]), cvt_pk_bf16(Sc[2 * ks][2], Sc[2 * ks][3]), cvt_pk_bf16(Sc[2 * ks + 1][0], Sc[2 * ks + 1][1]), cvt_pk_bf16(Sc[2 * ks + 1][2], Sc[2 * ks + 1][3])};
            if (k + 1 < 36) {
#pragma unroll
                for (int m = 0; m < 4; ++m) { wn[m][0] = wn2[m][0]; wn[m][1] = wn2[m][1]; kt[m][0] = kt2[m][0]; kt[m][1] = kt2[m][1]; uu[m] = uu2[m]; } }
        }
    }
}
__device__ __forceinline__ void phase_gdn_out(KA a, int l, LAS unsigned char* lds, int bid, int G) {
    const int tid = TIDX(), wave = tid >> 6, lane = tid & 63, fr = lane & 15, fq = lane >> 4;
    unsigned char* ws = a->ws; bf16_t* P = (bf16_t*)(ws + WS_P);
    const bf16_t* QN = (const bf16_t*)(ws + WS_QN); const bf16_t* KN = (const bf16_t*)(ws + WS_KN); const bf16_t* UT = (const bf16_t*)(ws + WS_UT); const float* GC = (const float*)(ws + WS_GC);
    LAS float* oL = (LAS float*)lds;
    const int c_lo = (l == DEPTH - 1) ? 4 : 0, ncu = 36 - c_lo;
    for (int u = bid; u < NB * ncu * 4; u += G) {
        const int h = u & 3, c = c_lo + (u >> 2) % ncu, b = (u >> 2) / ncu, row0 = gdn_row0(b, c);
        const size_t gu = (size_t)((b * 36 + c) * 4 + h);
        const int dir = wave >> 2, it_ = wave & 3; const size_t gu2 = gu * 2 + dir;
        const bf16_t* SOLD = (const bf16_t*)(ws + (dir ? WS_SOLD1 : WS_SOLD0)) + gu * 4096;
        const float* gcp = GC + gu2 * 64;
        bf16x8 qf[2];
#pragma unroll
        for (int ks = 0; ks < 2; ++ks) qf[ks] = *(const bf16x8*)(QN + gu * 4096 + (size_t)(16 * it_ + fr) * 64 + ks * 32 + fq * 8);
        const int i = 16 * it_ + fr; const float gi = gcp[i];
        u32x4 pf[2];
#pragma unroll
        for (int t = 0; t < 2; ++t) { f32x4 s2[2];
#pragma unroll
            for (int hh = 0; hh < 2; ++hh) { const int jt = 2 * t + hh; f32x4 acc = (f32x4){0.f, 0.f, 0.f, 0.f};
#pragma unroll
                for (int ks = 0; ks < 2; ++ks) { const bf16x8 kf = *(const bf16x8*)(KN + gu * 4096 + (size_t)(16 * jt + fr) * 64 + ks * 32 + fq * 8); acc = __builtin_amdgcn_mfma_f32_16x16x32_bf16(kf, qf[ks], acc, 0, 0, 0); }
                const f32x4 gj = *(const f32x4*)(gcp + 16 * jt + 4 * fq);
#pragma unroll
                for (int r = 0; r < 4; ++r) { const int j = 16 * jt + 4 * fq + r; const bool valid = dir ? (j >= i) : (j <= i); acc[r] = valid ? acc[r] * __expf(gi - gj[r]) : 0.f; }
                s2[hh] = acc; }
            pf[t] = (u32x4){cvt_pk_bf16(s2[0][0], s2[0][1]), cvt_pk_bf16(s2[0][2], s2[0][3]), cvt_pk_bf16(s2[1][0], s2[1][1]), cvt_pk_bf16(s2[1][2], s2[1][3])}; }
        const f32x4 gr = *(const f32x4*)(gcp + 16 * it_ + 4 * fq);
        float er[4];
#pragma unroll
        for (int r = 0; r < 4; ++r) er[r] = __expf(gr[r]);
        __syncthreads();
#pragma unroll
        for (int nt = 0; nt < 4; ++nt) { f32x4 o1 = (f32x4){0.f, 0.f, 0.f, 0.f}, o2 = o1;
#pragma unroll
            for (int t = 0; t < 2; ++t) { const bf16_t* vp = UT + gu2 * 4096 + (size_t)(16 * nt + fr) * 64 + 32 * t + 4 * fq; const u32x2 lo = *(const u32x2*)vp, hi2 = *(const u32x2*)(vp + 16);
                o1 = __builtin_amdgcn_mfma_f32_16x16x32_bf16(__builtin_bit_cast(bf16x8, pf[t]), __builtin_bit_cast(bf16x8, (u32x4){lo.x, lo.y, hi2.x, hi2.y}), o1, 0, 0, 0); }
#pragma unroll
            for (int ks = 0; ks < 2; ++ks) { const bf16x8 sfr = *(const bf16x8*)(SOLD + (size_t)(16 * nt + fr) * 64 + ks * 32 + fq * 8); o2 = __builtin_amdgcn_mfma_f32_16x16x32_bf16(qf[ks], sfr, o2, 0, 0, 0); }
#pragma unroll
            for (int r = 0; r < 4; ++r) oL[(dir * 64 + 16 * it_ + 4 * fq + r) * 68 + 16 * nt + fr] = o1[r] + o2[r] * er[r]; }
        __syncthreads();
        { const int ii = tid >> 3, g = tid & 7; const LAS float* p0 = oL + ii * 68 + 8 * g; const LAS float* p1 = p0 + 64 * 68;
          const f32x4 a0 = *(const LAS f32x4*)p0, a1 = *(const LAS f32x4*)(p0 + 4), b0 = *(const LAS f32x4*)p1, b1 = *(const LAS f32x4*)(p1 + 4);
          float o8[8]; float ss = 0.f;
#pragma unroll
          for (int j = 0; j < 4; ++j) { o8[j] = a0[j] + b0[j]; o8[4 + j] = a1[j] + b1[j]; }
#pragma unroll
          for (int j = 0; j < 8; ++j) ss += o8[j] * o8[j];
          ss += __shfl_xor(ss, 1); ss += __shfl_xor(ss, 2); ss += __shfl_xor(ss, 4);
          const float rs = rsqrtf(ss * (1.f / 64.f) + EPS);
          bf16_t* zp = P + (size_t)(row0 + ii) * PW + C_GZ + h * 64 + 8 * g; float z8[8]; unpack8(*(const u32x4*)zp, z8);
          const float* ng = a->gdn_norm_g + l * 64 + 8 * g; const f32x4 g0 = *(const f32x4*)ng, g1 = *(const f32x4*)(ng + 4);
          float y[8];
#pragma unroll
          for (int j = 0; j < 8; ++j) y[j] = o8[j] * rs * (j < 4 ? g0[j & 3] : g1[j & 3]) * silu_f(z8[j]);
          *(u32x4*)zp = pack8(y); }
    }
}

constexpr int STEPS_PER_LAYER = 11, N_STEPS = 1 + DEPTH * STEPS_PER_LAYER + 1;

__global__ void __launch_bounds__(512, 2) fwd_megakernel(Args a) {
    extern __shared__ __attribute__((aligned(16))) unsigned char lds_raw[];
    LAS unsigned char* lds = (LAS unsigned char*)lds_raw;
    cg::grid_group grid = cg::this_grid();
    const int bid = blockIdx.x, G = gridDim.x;
    const int st_lo = a.st_lo, st_hi = a.st_hi, coop = a.coop;
    KA ka = (KA)__builtin_amdgcn_kernarg_segment_ptr();
#define STEP(idx, call) do { const int _i = (idx); if (st_lo <= _i && _i < st_hi) { call; if (_i + 1 < st_hi) { if (coop) grid.sync(); else __syncthreads(); } } } while (0)
    STEP(0, phase_prologue(ka, lds, bid, G));
#if OPT_RET
#define RET_STEPS(l, s0) STEP(s0 + 5, phase_ret_kv(ka, l, lds, bid, G)); STEP(s0 + 6, phase_ret_out(ka, l, lds, bid, G));
#else
#define RET_STEPS(l, s0) STEP(s0 + 5, phase_ret_rec(ka, l, lds, bid, G)); STEP(s0 + 6, phase_ret_fin(ka, l, bid, G));
#endif
#if OPT_GDN
#define GDN_STEPS(l, s0) STEP(s0 + 2, phase_gdn_prep2(ka, l, lds, bid, G)); STEP(s0 + 3, phase_gdn_chain(ka, l, bid, G)); STEP(s0 + 4, phase_gdn_out(ka, l, lds, bid, G));
#else
#define GDN_STEPS(l, s0) STEP(s0 + 2, phase_gdn_prep(ka, l, bid, G)); STEP(s0 + 3, phase_gdn_rec(ka, l, lds, bid, G)); STEP(s0 + 4, phase_gdn_fin(ka, l, bid, G));
#endif
#define LAYER(l) do { constexpr int s0 = 1 + (l) * STEPS_PER_LAYER; \
        STEP(s0 + 0, phase_norm(ka, l, bid, G)); \
        STEP(s0 + 1, phase_gemm(ka, l, false, lds, bid, G)); \
        GDN_STEPS(l, s0) \
        RET_STEPS(l, s0) \
        STEP(s0 + 7, phase_sg1(ka, l, bid, G)); \
        STEP(s0 + 8, phase_sg2(ka, l, lds, bid, G)); \
        STEP(s0 + 9, phase_sc(ka, l, bid, G)); \
        STEP(s0 + 10, phase_gemm(ka, l, true, lds, bid, G)); } while (0)
    LAYER(0); LAYER(1); LAYER(2); LAYER(3);
    STEP(N_STEPS - 1, phase_norm(ka, DEPTH, bid, G));
#undef STEP
}

extern "C" void kernel_launch(void* const* d_in, const int* in_sizes, int n_in, void* d_out, int out_size, void* d_ws, size_t ws_size, hipStream_t stream) {
    static int grid = 0;
    if (grid == 0) {
        int dev = 0, cus = 0, per_cu = 0;
        hipGetDevice(&dev); hipDeviceGetAttribute(&cus, hipDeviceAttributeMultiprocessorCount, dev);
        if (hipFuncSetAttribute((const void*)fwd_megakernel, hipFuncAttributeMaxDynamicSharedMemorySize, LDS_BYTES) != hipSuccess) { fprintf(stderr, "hipFuncSetAttribute failed\n"); grid = -1; return; }
        if (hipOccupancyMaxActiveBlocksPerMultiprocessor(&per_cu, (const void*)fwd_megakernel, 512, LDS_BYTES) != hipSuccess || per_cu < 1) { fprintf(stderr, "occupancy query failed (%d)\n", per_cu); per_cu = 1; }
        (void)hipGetLastError();
        grid = cus * per_cu;
        if (ws_size < WS_END2) { fprintf(stderr, "workspace too small: %zu < %zu\n", ws_size, (size_t)WS_END); grid = -1; return; }
    }
    if (grid < 0) return;
    Args a{};
    const float** ap = (const float**)&a;
    for (int i = 0; i < 18; ++i) ap[i] = (const float*)d_in[i];
    a.out = (float*)d_out; a.ws = (unsigned char*)d_ws;
    hipMemsetAsync((char*)d_ws + WS_CTL, 0, 4096, stream);
#if MK_MULTI
    for (int st = 0; st < N_STEPS; ++st) { a.st_lo = st; a.st_hi = st + 1; a.coop = 0; hipLaunchKernelGGL(fwd_megakernel, dim3(grid), dim3(512), LDS_BYTES, stream, a); }
#else
    a.st_lo = 0; a.st_hi = N_STEPS; a.coop = 1;
    void* args[] = {&a};
    hipError_t e = hipLaunchCooperativeKernel((const void*)fwd_megakernel, dim3(grid), dim3(512), args, LDS_BYTES, stream);
    if (e != hipSuccess) fprintf(stderr, "cooperative launch failed: %s (grid %d)\n", hipGetErrorString(e), grid);
#endif
}
```

```cpp
#include <hip/hip_runtime.h>
#include <hip/hip_cooperative_groups.h>
#include <cstdint>
#include <cstdio>
namespace cg = cooperative_groups;

#ifndef EXP_NOINPLACE
#define EXP_NOINPLACE 0
#endif
#ifndef EXP_NJ
#define EXP_NJ 18
#endif
#ifndef OPT_GDN
#define OPT_GDN 1
#endif
#ifndef OPT_SG
#define OPT_SG 1
#endif
#ifndef PROBE_K
#define PROBE_K -1
#endif
#ifndef PROBE_R
#define PROBE_R 0
#endif
#ifndef OPT_RET
#define OPT_RET 1
#endif
#ifndef MK_MULTI
#define MK_MULTI 0
#endif

#define LAS __attribute__((address_space(3)))
__device__ __forceinline__ int TIDX() { int t = threadIdx.x; asm volatile("" : "+v"(t)); return t; }
typedef unsigned short bf16_t;
typedef short bf16x8 __attribute__((ext_vector_type(8)));
typedef float f32x4 __attribute__((ext_vector_type(4)));
typedef float f32x2 __attribute__((ext_vector_type(2)));
typedef unsigned u32x4 __attribute__((ext_vector_type(4)));
typedef unsigned u32x2 __attribute__((ext_vector_type(2)));

constexpr int DM = 1024, NB = 16, TL = 2048, TC = 256, DEPTH = 4;
constexpr int RL = NB * TL, RC = NB * TC, RT = RL + RC;
constexpr int PW = 3840, INW = 3856;
constexpr float EPS = 1e-6f;
constexpr unsigned long long POSPACK = 0xCEDBA9786543210ull;
constexpr int C_RQ = 0, C_RK = 256, C_RV = 512, C_RZ = 768, C_SU = 1024, C_SV = 1280, C_SZ = 1536, C_CC = 1792, C_CB = 2048, C_CH = 2304, C_CZ = 2560,
              C_GQ = 2816, C_GZ = 3072, C_GK = 3328, C_GV = 3584;

constexpr size_t MiB = 1u << 20;
constexpr size_t WS_CTL = 0;
constexpr size_t WS_ROPE = 512 * 1024;
constexpr size_t WS_MOD = 1 * MiB;
constexpr size_t WS_WEXT = 2 * MiB;
constexpr size_t WS_WIN = 3 * MiB;
constexpr size_t WS_WOUT = 33 * MiB;
constexpr size_t WS_XC = 41 * MiB;
constexpr size_t WS_EXT = 57 * MiB;
constexpr size_t WS_KV = 60 * MiB;
constexpr size_t WS_X = 78 * MiB;
constexpr size_t WS_O = WS_X, WS_H = WS_X + 72 * MiB;
constexpr size_t WS_P = 222 * MiB;
constexpr size_t WS_GB = 492 * MiB;
constexpr size_t WS_END = 495 * MiB;
constexpr size_t WS_OG = WS_X;
constexpr size_t WS_GQ = WS_X + 72 * MiB, WS_GK = WS_GQ + 18 * MiB, WS_GV = WS_GK + 18 * MiB;
constexpr size_t WS_SGV = WS_X + 72 * MiB;

constexpr int LDS_BYTES = 147456;

struct Args {
    const float *x, *c, *ctx, *c_ctx, *w_mod, *b_mod, *g_pre, *g_post, *w_in, *w_out, *ret_norm_g, *sg_w, *sg_b, *sc_conv_w, *gdn_conv_w, *gdn_a_log, *gdn_dt_bias, *gdn_norm_g;
    float* out; unsigned char* ws; int st_lo, st_hi, coop, pad;
};

typedef const __attribute__((address_space(4))) Args* KA;

__device__ __forceinline__ float bf2f(unsigned v) { return __uint_as_float(v << 16); }
typedef __bf16 bf16v2_t __attribute__((ext_vector_type(2)));
__device__ __forceinline__ unsigned cvt_pk_bf16(float lo, float hi) { const f32x2 f = {lo, hi}; return __builtin_bit_cast(unsigned, __builtin_convertvector(f, bf16v2_t)); }
__device__ __forceinline__ unsigned f2bf(float f) { return cvt_pk_bf16(f, 0.f) & 0xffffu; }
__device__ __forceinline__ float wave_sum(float v) {
#pragma unroll
    for (int o = 1; o < 64; o <<= 1) v += __shfl_xor(v, o);
    return v;
}
__device__ __forceinline__ float silu_f(float x) { return x / (1.f + __expf(-x)); }
__device__ __forceinline__ float gelu_f(float x) { const float u = 0.7978845608028654f * (x + 0.044715f * x * x * x); return x / (1.f + __expf(-2.f * u)); }
__device__ __forceinline__ float softplus_f(float x) { return x > 20.f ? x : log1pf(__expf(x)); }
__device__ __forceinline__ float sigmoid_f(float x) { return 1.f / (1.f + __expf(-x)); }

namespace pg8 {
constexpr int BM = 256, BK = 64, HALF = 128, HTB = HALF * BK * 2, STAGE_BYTES = 8 * HTB, NXCD = 8, WGM = 8;
__host__ __device__ __forceinline__ int lds_byte(int r, int c) { const int st = (r >> 4) * 2 + (c >> 5), rr = r & 15, cc = c & 31, ob = rr * 64 + cc * 2; return st * 1024 + (ob ^ (((ob >> 9) & 1) << 5)); }
__host__ __device__ __forceinline__ void stage_rc(int b, int& R, int& C) { const int st = b / 1024, sb = b % 1024, swz = sb ^ (((sb >> 9) & 1) << 5); R = (st >> 1) * 16 + swz / 64; C = (st & 1) * 32 + (swz % 64) / 2; }
__host__ __device__ __forceinline__ int perm32(int rho) { const int n = rho >> 4, i = rho & 15; return 8 * (i >> 2) + 4 * n + (i & 3); }
struct Unit { int pm, pn; };
struct Gemm { const bf16_t* A; const bf16_t* Bt; int M, N, K, lda, seg; };
struct StaticOrder {
    int nM, nN, nwg, G, c;
    __host__ __device__ void init(int M, int N, int G_, int c_) { nM = M / BM; nN = N / BM; nwg = nM * nN; G = G_; c = c_; }
    __host__ __device__ bool next(int i, Unit& u) const {
        const long L = (long)i * G + c; if (L >= nwg) return false;
        int wgid = (int)L; { const int q = nwg / NXCD, r = nwg % NXCD, xcd = wgid % NXCD, off = wgid / NXCD; wgid = (xcd < r ? xcd * (q + 1) : r * (q + 1) + (xcd - r) * q) + off; }
        const int nig = WGM * nN, gid = wgid / nig, fm = gid * WGM, gsz = (nM - fm) < WGM ? (nM - fm) : WGM;
        u.pm = fm + ((wgid % nig) % gsz); u.pn = (wgid % nig) / gsz; return true;
    }
};
struct EpiBf16 {
    bf16_t* O; int ldc;
    __device__ __forceinline__ void operator()(const f32x4 (&acc)[2][2][4][2], const Unit& u, int wr, int wc, int fr, int fq) const {
        const int row0 = u.pm * BM + wr * 64 + fr, col0 = u.pn * BM + wc * 32 + 8 * fq;
#pragma unroll
        for (int ai = 0; ai < 2; ++ai)
#pragma unroll
            for (int m = 0; m < 4; ++m) { bf16_t* rowp = O + (size_t)(row0 + ai * HALF + m * 16) * ldc + col0;
#pragma unroll
                for (int bj = 0; bj < 2; ++bj) { const f32x4 v0 = acc[ai][bj][m][0], v1 = acc[ai][bj][m][1];
                    u32x4 w; w.x = cvt_pk_bf16(v0[0], v0[1]); w.y = cvt_pk_bf16(v0[2], v0[3]); w.z = cvt_pk_bf16(v1[0], v1[1]); w.w = cvt_pk_bf16(v1[2], v1[3]);
                    *(u32x4*)(rowp + bj * HALF) = w; } }
    }
};

template <class Epi>
__device__ __forceinline__ void gemm_phase(LAS unsigned char* lds, const Gemm g, const StaticOrder& S, const Epi& E) {
    const int tid = TIDX(), wid = __builtin_amdgcn_readfirstlane(tid >> 6), lane = tid & 63, wr = wid >> 2, wc = wid & 3, fr = lane & 15, fq = lane >> 4;
    const int K = g.K, nt = K / BK, lda = g.lda, seg = g.seg;
    unsigned voffA[2], voffB[2];
#pragma unroll
    for (int i = 0; i < 2; ++i) { int R, C; stage_rc(tid * 16 + i * 8192, R, C); const int Rb = (R & ~31) + perm32(R & 31);
        voffA[i] = (unsigned)(R * lda + C) * 2u; voffB[i] = (unsigned)(Rb * K + C) * 2u; }
    const size_t kstep = (size_t)(BK * 2);
    const size_t hstepA = (size_t)HALF * lda * 2, hstepB = (size_t)HALF * K * 2;
    const size_t tstepA = 2 * hstepA, tstepB = 2 * hstepB;
#define KOFFA(t) (seg ? ((size_t)((t) >> 2) * 2048 + (size_t)((t) & 3) * 128) : (size_t)(t) * 128)
    const unsigned ldsw = (unsigned)wid * 1024u;
    const int aoff = lds_byte(wr * 64 + fr, fq * 8), boff = lds_byte(wc * 32 + fr, fq * 8);
#define PG8_SA(b, h) (((b) * 2 + (h)) * HTB)
#define PG8_SB(b, h) ((4 + (b) * 2 + (h)) * HTB)
#define PG8_STAGE(bufoff, gbase, voff) do { _Pragma("unroll") for (int _i = 0; _i < 2; ++_i) \
        __builtin_amdgcn_global_load_lds((const unsigned*)((const char*)(gbase) + (voff)[_i]), (LAS unsigned*)(lds + (bufoff) + ldsw + _i * 8192), 16, 0, 0); } while (0)
#define PG8_LDA(dst, b, h) do { _Pragma("unroll") for (int m = 0; m < 4; ++m) _Pragma("unroll") for (int k = 0; k < 2; ++k) dst[m][k] = *(const LAS bf16x8*)(lds + PG8_SA(b, h) + aoff + m * 2048 + k * 1024); } while (0)
#define PG8_LDB(dst, b, h) do { _Pragma("unroll") for (int n = 0; n < 2; ++n) _Pragma("unroll") for (int k = 0; k < 2; ++k) dst[n][k] = *(const LAS bf16x8*)(lds + PG8_SB(b, h) + boff + n * 2048 + k * 1024); } while (0)
#define PG8_MMA(ai, bj, At, Bt) do { __builtin_amdgcn_s_setprio(1); _Pragma("unroll") for (int m = 0; m < 4; ++m) _Pragma("unroll") for (int n = 0; n < 2; ++n) _Pragma("unroll") for (int k = 0; k < 2; ++k) \
        acc[ai][bj][m][n] = __builtin_amdgcn_mfma_f32_16x16x32_bf16(Bt[n][k], At[m][k], acc[ai][bj][m][n], 0, 0, 0); __builtin_amdgcn_s_setprio(0); } while (0)
#define PG8_WAIT_V(n) asm volatile("s_waitcnt vmcnt(" #n ")" ::: "memory")
#define PG8_WAIT_L(n) asm volatile("s_waitcnt lgkmcnt(" #n ")" ::: "memory")
#define PG8_BAR __builtin_amdgcn_s_barrier()
#define PG8_SCHED __builtin_amdgcn_sched_barrier(0)
    Unit cur, nxt; int ui = 0;
    if (!S.next(0, cur)) return;
    f32x4 acc[2][2][4][2];
#pragma unroll
    for (int a = 0; a < 2; ++a)
#pragma unroll
        for (int b = 0; b < 2; ++b)
#pragma unroll
            for (int m = 0; m < 4; ++m)
#pragma unroll
                for (int n = 0; n < 2; ++n) acc[a][b][m][n] = (f32x4){0.f, 0.f, 0.f, 0.f};
    bf16x8 At[4][2], B0[2][2], B1[2][2];
    const char* cA = (const char*)g.A + (size_t)cur.pm * tstepA; const char* cB = (const char*)g.Bt + (size_t)cur.pn * tstepB;
    PG8_STAGE(PG8_SB(0, 0), cB, voffB); PG8_STAGE(PG8_SB(0, 1), cB + hstepB, voffB); PG8_STAGE(PG8_SA(0, 0), cA, voffA); PG8_STAGE(PG8_SA(0, 1), cA + hstepA, voffA);
    if (wr == 1) PG8_BAR;
    PG8_WAIT_V(2); PG8_BAR;
    PG8_STAGE(PG8_SB(1, 0), cB + kstep, voffB); PG8_STAGE(PG8_SA(1, 0), cA + KOFFA(1), voffA); PG8_STAGE(PG8_SB(1, 1), cB + hstepB + kstep, voffB);
    PG8_WAIT_V(6); PG8_BAR;
    for (;;) {
        const bool has_next = S.next(ui + 1, nxt);
        const char* nA = has_next ? (const char*)g.A + (size_t)nxt.pm * tstepA : cA; const char* nB = has_next ? (const char*)g.Bt + (size_t)nxt.pn * tstepB : cB;
        for (int t = 0; t < nt; t += 2) {
            const bool last = (t == nt - 2);
            const char* a1 = cA + KOFFA(t + 1);
            const char* a2 = last ? nA : cA + KOFFA(t + 2); const char* b2 = last ? nB : cB + (size_t)(t + 2) * kstep;
            const char* a3 = last ? nA + KOFFA(1) : cA + KOFFA(t + 3); const char* b3 = b2 + kstep;
            PG8_LDB(B0, 0, 0); PG8_LDB(B1, 0, 1); PG8_SCHED; PG8_LDA(At, 0, 0); PG8_STAGE(PG8_SA(1, 1), a1 + hstepA, voffA);
            PG8_WAIT_V(8); PG8_WAIT_L(0); PG8_BAR; PG8_MMA(0, 0, At, B0); PG8_MMA(0, 1, At, B1); PG8_BAR; PG8_SCHED;
            PG8_LDA(At, 0, 1); PG8_STAGE(PG8_SB(0, 0), b2, voffB); PG8_STAGE(PG8_SB(0, 1), b2 + hstepB, voffB); PG8_STAGE(PG8_SA(0, 0), a2, voffA);
            PG8_WAIT_V(8); PG8_WAIT_L(0); PG8_BAR; PG8_MMA(1, 0, At, B0); PG8_MMA(1, 1, At, B1); PG8_BAR; PG8_SCHED;
            PG8_LDB(B0, 1, 0); PG8_LDB(B1, 1, 1); PG8_SCHED; PG8_LDA(At, 1, 0); PG8_STAGE(PG8_SA(0, 1), a2 + hstepA, voffA);
            PG8_WAIT_V(8); PG8_WAIT_L(0); PG8_BAR; PG8_MMA(0, 0, At, B0); PG8_MMA(0, 1, At, B1); PG8_BAR; PG8_SCHED;
            PG8_LDA(At, 1, 1); PG8_STAGE(PG8_SB(1, 0), b3, voffB); PG8_STAGE(PG8_SB(1, 1), b3 + hstepB, voffB); PG8_STAGE(PG8_SA(1, 0), a3, voffA);
            PG8_WAIT_V(8); PG8_WAIT_L(0); PG8_BAR; PG8_MMA(1, 0, At, B0); PG8_MMA(1, 1, At, B1); PG8_BAR; PG8_SCHED;
        }
        if (wr == 0) PG8_BAR;
        E(acc, cur, wr, wc, fr, fq);
        if (!has_next) break;
#pragma unroll
        for (int a = 0; a < 2; ++a)
#pragma unroll
            for (int b = 0; b < 2; ++b)
#pragma unroll
                for (int m = 0; m < 4; ++m)
#pragma unroll
                    for (int n = 0; n < 2; ++n) acc[a][b][m][n] = (f32x4){0.f, 0.f, 0.f, 0.f};
        cur = nxt; cA = nA; cB = nB; ++ui;
        if (wr == 1) PG8_BAR;
    }
    PG8_WAIT_V(0);
    PG8_BAR;
#undef KOFFA
#undef PG8_SA
#undef PG8_SB
#undef PG8_STAGE
#undef PG8_LDA
#undef PG8_LDB
#undef PG8_MMA
#undef PG8_WAIT_V
#undef PG8_WAIT_L
#undef PG8_BAR
#undef PG8_SCHED
}
}

__device__ __forceinline__ int seq_row(int b, int s) { return s < TC ? RL + b * TC + s : b * TL + (s - TC); }

__device__ __forceinline__ void transpose_item(const float* W, int N, int item, int nblk, bf16_t* dst_main, bf16_t* dst_ext, bool is_in, LAS float* scr, int lane) {
    const int kb = item / nblk, nb = item % nblk, k0 = 64 * kb, n0 = 32 * nb;
    { const int n = n0 + (lane & 31);
#pragma unroll 8
      for (int i = 0; i < 32; ++i) { const int kk = 2 * i + (lane >> 5); scr[kk * 33 + (lane & 31)] = n < N ? W[(size_t)(k0 + kk) * N + n] : 0.f; } }
    asm volatile("s_waitcnt lgkmcnt(0)" ::: "memory");
    const int c = lane & 7;
#pragma unroll
    for (int j = 0; j < 4; ++j) { const int nl = (lane >> 3) + 8 * j, n = n0 + nl; const LAS float* s = scr + (8 * c) * 33 + nl;
        u32x4 o; o.x = cvt_pk_bf16(s[0 * 33], s[1 * 33]); o.y = cvt_pk_bf16(s[2 * 33], s[3 * 33]); o.z = cvt_pk_bf16(s[4 * 33], s[5 * 33]); o.w = cvt_pk_bf16(s[6 * 33], s[7 * 33]);
        if (n < N) { bf16_t* rowp;
            if (is_in) { if (n < PW) { const int sg = n >> 8, pos = (int)((POSPACK >> (4 * sg)) & 15ull); rowp = dst_main + (size_t)(pos * 256 + (n & 255)) * DM; } else rowp = dst_ext + (size_t)(n - PW) * DM; }
            else rowp = dst_main + (size_t)n * DM;
            *(u32x4*)(rowp + k0 + 8 * c) = o; } }
    asm volatile("s_waitcnt lgkmcnt(0)" ::: "memory");
}

__device__ __forceinline__ void phase_prologue(KA a, LAS unsigned char* lds, int bid, int G) {
    const int tid = TIDX(), wave = tid >> 6, lane = tid & 63;
    unsigned char* ws = a->ws;
    if (bid == G - 1) { float* rope = (float*)(ws + WS_ROPE);
        for (int i = tid; i < 1024; i += 512) { const int pos = i >> 4, f = i & 15; const float inv = expf(-9.210340371976184f * (float)f * (1.f / 16.f)); const float ang = (float)pos * inv;
            rope[i] = cosf(ang); rope[1024 + i] = sinf(ang); } }
    for (int it = bid; it < 96; it += G) {
        LAS float* s = (LAS float*)lds;
        for (int i = tid; i < 17 * 1024; i += 512) { const int r = i >> 10, k = i & 1023; const float v = r < 16 ? a->c[r * 1024 + k] : a->c_ctx[k]; s[i] = silu_f(v); }
        __syncthreads();
        const int l = it / 24, j0 = (it % 24) * 128;
        f32x2 acc[17];
#pragma unroll
        for (int r = 0; r < 17; ++r) acc[r] = (f32x2){0.f, 0.f};
        const float* wp = a->w_mod + ((size_t)l * 1024 + wave * 128) * 3072 + j0 + lane * 2;
#pragma unroll 4
        for (int k = 0; k < 128; ++k) { const f32x2 w2 = *(const f32x2*)(wp + (size_t)k * 3072);
#pragma unroll
            for (int r = 0; r < 17; ++r) { const float sv = s[r * 1024 + wave * 128 + k]; acc[r] += sv * w2; } }
        __syncthreads();
        LAS float* part = (LAS float*)lds;
#pragma unroll
        for (int r = 0; r < 17; ++r) *(LAS f32x2*)(part + (wave * 17 + r) * 128 + lane * 2) = acc[r];
        __syncthreads();
        float* mod = (float*)(ws + WS_MOD);
        for (int i = tid; i < 17 * 128; i += 512) { const int r = i >> 7, cc = i & 127; float v = a->b_mod[l * 3072 + j0 + cc];
#pragma unroll
            for (int w = 0; w < 8; ++w) v += part[(w * 17 + r) * 128 + cc];
            mod[((size_t)l * 17 + r) * 3072 + j0 + cc] = v; }
        __syncthreads();
    }
    __syncthreads();
    { bf16_t* sgw = (bf16_t*)(ws + 2 * MiB + 256 * 1024);
      for (int i = bid * 512 + tid; i < DEPTH * 4 * 128 * 128 / 8; i += G * 512) { const f32x4 x0 = *(const f32x4*)(a->sg_w + (size_t)i * 8), x1 = *(const f32x4*)(a->sg_w + (size_t)i * 8 + 4);
          u32x4 w; w.x = cvt_pk_bf16(x0[0], x0[1]); w.y = cvt_pk_bf16(x0[2], x0[3]); w.z = cvt_pk_bf16(x1[0], x1[1]); w.w = cvt_pk_bf16(x1[2], x1[3]); *(u32x4*)(sgw + (size_t)i * 8) = w; } }
    LAS float* scr = (LAS float*)lds + wave * (64 * 33);
    const int gw = bid * 8 + wave, NGW = G * 8;
    constexpr int I_IN = 16 * 121, I_OUT = 16 * 32, NIT = DEPTH * (I_IN + I_OUT);
    for (int it = gw; it < NIT; it += NGW) {
        const int l = it / (I_IN + I_OUT), r = it % (I_IN + I_OUT);
        if (r < I_IN) transpose_item(a->w_in + (size_t)l * DM * INW, INW, r, 121, (bf16_t*)(ws + WS_WIN) + (size_t)l * PW * DM, (bf16_t*)(ws + WS_WEXT) + (size_t)l * 16 * DM, true, scr, lane);
        else transpose_item(a->w_out + (size_t)l * DM * DM, DM, r - I_IN, 32, (bf16_t*)(ws + WS_WOUT) + (size_t)l * DM * DM, nullptr, false, scr, lane);
    }
}

__device__ __forceinline__ void phase_norm(KA a, int l, int bid, int G, bool st = true) {
    const int tid = TIDX(), wave = tid >> 6, lane = tid & 63;
    unsigned char* ws = a->ws;
    const float* mod = (const float*)(ws + WS_MOD);
    const bf16_t* O = (const bf16_t*)(ws + WS_O); bf16_t* H = (bf16_t*)(ws + WS_H); float* XC = (float*)(ws + WS_XC);
    const int nrows = (l == DEPTH) ? RL : RT, stride = G * 8;
    auto xptr = [&](int r) { const bool is_ctx = r >= RL; return (l <= 1) ? (is_ctx ? a->ctx + (size_t)(r - RL) * DM : a->x + (size_t)r * DM) : (is_ctx ? XC + (size_t)(r - RL) * DM : a->out + (size_t)r * DM); };
    f32x4 gp4[4], gpre4[4];
#pragma unroll
    for (int j = 0; j < 4; ++j) { const int col = 4 * lane + 256 * j;
        gp4[j] = (l > 0) ? *(const f32x4*)(a->g_post + (size_t)(l - 1) * DM + col) : (f32x4){0.f, 0.f, 0.f, 0.f};
        gpre4[j] = (l < DEPTH) ? *(const f32x4*)(a->g_pre + (size_t)l * DM + col) : (f32x4){0.f, 0.f, 0.f, 0.f}; }
    int r = bid * 8 + wave;
    f32x4 vn[4], gtn[4], shn[4], scn[4]; u32x2 on[4];
    auto prefetch = [&](int rr) { const float* xp = xptr(rr); const int mr = rr >= RL ? 16 : (rr >> 11);
        const float* gate = mod + ((size_t)(l > 0 ? l - 1 : 0) * 17 + mr) * 3072 + 2048; const float* mrow = mod + ((size_t)(l < DEPTH ? l : 0) * 17 + mr) * 3072;
#pragma unroll
        for (int j = 0; j < 4; ++j) { const int col = 4 * lane + 256 * j; vn[j] = __builtin_nontemporal_load((const f32x4*)(xp + col));
            if (l > 0) { on[j] = __builtin_nontemporal_load((const u32x2*)(O + (size_t)rr * DM + col)); gtn[j] = *(const f32x4*)(gate + col); }
            if (l < DEPTH) { shn[j] = *(const f32x4*)(mrow + col); scn[j] = *(const f32x4*)(mrow + 1024 + col); } } };
    if (r < nrows) prefetch(r);
    for (; r < nrows; r += stride) {
        const bool is_ctx = r >= RL;
        f32x4 v[4], gt[4], sh[4], sc[4]; u32x2 ow[4];
#pragma unroll
        for (int j = 0; j < 4; ++j) { v[j] = vn[j]; ow[j] = on[j]; gt[j] = gtn[j]; sh[j] = shn[j]; sc[j] = scn[j]; }
        if (r + stride < nrows) prefetch(r + stride);
        if (l > 0) {
            f32x4 o[4]; float ss = 0.f;
#pragma unroll
            for (int j = 0; j < 4; ++j) { const u32x2 w = ow[j];
                o[j] = (f32x4){bf2f(w.x & 0xffffu), bf2f(w.x >> 16), bf2f(w.y & 0xffffu), bf2f(w.y >> 16)};
                ss += o[j][0] * o[j][0] + o[j][1] * o[j][1] + o[j][2] * o[j][2] + o[j][3] * o[j][3]; }
            const float rs = rsqrtf(wave_sum(ss) * (1.f / DM) + EPS);
            float* xo = is_ctx ? XC + (size_t)(r - RL) * DM : a->out + (size_t)r * DM;
#pragma unroll
            for (int j = 0; j < 4; ++j) { const int col = 4 * lane + 256 * j;
                v[j] += gt[j] * (o[j] * rs * gp4[j]); if (st) __builtin_nontemporal_store(v[j], (f32x4*)(xo + col)); }
        }
        if (l < DEPTH) {
            float ss = 0.f;
#pragma unroll
            for (int j = 0; j < 4; ++j) ss += v[j][0] * v[j][0] + v[j][1] * v[j][1] + v[j][2] * v[j][2] + v[j][3] * v[j][3];
            const float rs = rsqrtf(wave_sum(ss) * (1.f / DM) + EPS);
#pragma unroll
            for (int j = 0; j < 4; ++j) { const int col = 4 * lane + 256 * j;
                const f32x4 h = v[j] * rs * gpre4[j] * (sc[j] + 1.f) + sh[j]; u32x2 w; w.x = cvt_pk_bf16(h[0], h[1]); w.y = cvt_pk_bf16(h[2], h[3]);
                if (st) *(u32x2*)(H + (size_t)r * DM + col) = w; }
        }
    }
}

__device__ __forceinline__ void ext_unit(KA a, int l, int u) {
    const int tid = TIDX(), wave = tid >> 6, lane = tid & 63, fr = lane & 15, fq = lane >> 4;
    const bf16_t* H = (const bf16_t*)(a->ws + WS_H); const bf16_t* We = (const bf16_t*)(a->ws + WS_WEXT) + (size_t)l * 16 * DM; float* EXT = (float*)(a->ws + WS_EXT);
    const int row0 = u * 256 + wave * 32;
    f32x4 acc[2] = {(f32x4){0.f, 0.f, 0.f, 0.f}, (f32x4){0.f, 0.f, 0.f, 0.f}};
    const bf16_t* ap0 = H + (size_t)(row0 + fr) * DM + fq * 8; const bf16_t* ap1 = ap0 + 16 * DM; const bf16_t* bp = We + (size_t)fr * DM + fq * 8;
#pragma unroll 8
    for (int ks = 0; ks < 32; ++ks) { const bf16x8 b = *(const bf16x8*)(bp + ks * 32), a0 = *(const bf16x8*)(ap0 + ks * 32), a1 = *(const bf16x8*)(ap1 + ks * 32);
        acc[0] = __builtin_amdgcn_mfma_f32_16x16x32_bf16(a0, b, acc[0], 0, 0, 0); acc[1] = __builtin_amdgcn_mfma_f32_16x16x32_bf16(a1, b, acc[1], 0, 0, 0); }
#pragma unroll
    for (int mt = 0; mt < 2; ++mt)
#pragma unroll
        for (int r = 0; r < 4; ++r) EXT[(size_t)(row0 + 16 * mt + fq * 4 + r) * 16 + fr] = acc[mt][r];
}
__device__ __forceinline__ void phase_gemm(KA a, int l, bool is_out, LAS unsigned char* lds, int bid, int G) {
    const int M = (is_out && l == DEPTH - 1) ? RL : RT, N = is_out ? DM : PW;
    pg8::Gemm g;
    g.A = is_out ? (const bf16_t*)(a->ws + WS_P) : (const bf16_t*)(a->ws + WS_H);
    g.Bt = is_out ? (const bf16_t*)(a->ws + WS_WOUT) + (size_t)l * DM * DM : (const bf16_t*)(a->ws + WS_WIN) + (size_t)l * PW * DM;
    g.M = M; g.N = N; g.K = DM; g.lda = is_out ? PW : DM; g.seg = is_out ? 1 : 0;
    pg8::StaticOrder S; S.init(M, N, G, bid);
    pg8::EpiBf16 E{is_out ? (bf16_t*)(a->ws + WS_O) : (bf16_t*)(a->ws + WS_P), N};
    pg8::gemm_phase<pg8::EpiBf16>(lds, g, S, E);
    if (!is_out) { const int nwg = (RT / 256) * (PW / 256), first = nwg % G;
        for (int u = (bid - first + G) % G; u < RT / 256; u += G) ext_unit(a, l, u); }
}

__device__ __forceinline__ void phase_sc(KA a, int l, int bid, int G, bool st = true) {
    bf16_t* P = (bf16_t*)(a->ws + WS_P); const float* cw = a->sc_conv_w + (size_t)l * 3 * 256;
    const int nrows = (l == DEPTH - 1) ? RL : RT;
    for (int it = bid * 512 + TIDX(); it < nrows * 32; it += G * 512) {
        const int r = it >> 5, c8 = (it & 31) * 8; const bool is_ctx = r >= RL; const int t = is_ctx ? ((r - RL) & 255) : (r & 2047), len = is_ctx ? TC : TL;
        bf16_t* row = P + (size_t)r * PW;
        float ch[3][8];
#pragma unroll
        for (int d = 0; d < 3; ++d) { const int tt = t + d - 1, tc = tt < 0 ? 0 : (tt >= len ? len - 1 : tt); const float mk = (tt == tc) ? 1.f : 0.f;
            const u32x4 cv = *(const u32x4*)(row + (ptrdiff_t)(tc - t) * PW + C_CC + c8), hv = *(const u32x4*)(row + (ptrdiff_t)(tc - t) * PW + C_CH + c8);
#pragma unroll
            for (int e = 0; e < 4; ++e) { ch[d][2 * e] = mk * bf2f(cv[e] & 0xffffu) * bf2f(hv[e] & 0xffffu); ch[d][2 * e + 1] = mk * bf2f(cv[e] >> 16) * bf2f(hv[e] >> 16); } }
        const u32x4 bv = __builtin_nontemporal_load((const u32x4*)(row + C_CB + c8)), zv = __builtin_nontemporal_load((const u32x4*)(row + C_CZ + c8));
        float y[8];
#pragma unroll
        for (int e = 0; e < 8; ++e) { const float conv = cw[c8 + e] * ch[0][e] + cw[256 + c8 + e] * ch[1][e] + cw[512 + c8 + e] * ch[2][e];
            const float bb = bf2f((e & 1) ? (bv[e >> 1] >> 16) : (bv[e >> 1] & 0xffffu)), zz = bf2f((e & 1) ? (zv[e >> 1] >> 16) : (zv[e >> 1] & 0xffffu));
            y[e] = bb * conv * silu_f(zz); }
        u32x4 o; o.x = cvt_pk_bf16(y[0], y[1]); o.y = cvt_pk_bf16(y[2], y[3]); o.z = cvt_pk_bf16(y[4], y[5]); o.w = cvt_pk_bf16(y[6], y[7]);
        if (st) *(u32x4*)(row + C_CB + c8) = o;
    }
}
__device__ __forceinline__ void phase_sg1(KA a, int l, int bid, int G) {
    const int wave = TIDX() >> 6, lane = TIDX() & 63;
    const bf16_t* P = (const bf16_t*)(a->ws + WS_P); float* SGV = (float*)(a->ws + WS_SGV);
    const int nrows = (l == DEPTH - 1) ? RL : RT;
    for (int r = bid * 8 + wave; r < nrows; r += G * 8) {
        const u32x2 w = *(const u32x2*)(P + (size_t)r * PW + C_SV + 4 * lane);
        f32x4 v = (f32x4){gelu_f(bf2f(w.x & 0xffffu)), gelu_f(bf2f(w.x >> 16)), gelu_f(bf2f(w.y & 0xffffu)), gelu_f(bf2f(w.y >> 16))};
        const float mu = wave_sum(v[0] + v[1] + v[2] + v[3]) * (1.f / 256.f); v = v - mu;
        const float var = wave_sum(v[0] * v[0] + v[1] * v[1] + v[2] * v[2] + v[3] * v[3]) * (1.f / 256.f);
        *(f32x4*)(SGV + (size_t)r * 256 + 4 * lane) = v * rsqrtf(var + EPS);
    }
}
__device__ __forceinline__ void phase_sg2(KA a, int l, LAS unsigned char* lds, int bid, int G) {
    const int tid = TIDX(); bf16_t* P = (bf16_t*)(a->ws + WS_P); const float* SGV = (const float*)(a->ws + WS_SGV);
    LAS float* sv = (LAS float*)lds;
    const int nch = (l == DEPTH - 1) ? 16 : 18;
    for (int it = bid; it < NB * nch; it += G) {
        const int b = it / nch, c = it % nch, base = c < 16 ? b * TL + c * 128 : RL + b * TC + (c - 16) * 128;
        __syncthreads();
        for (int i = tid; i < 128 * 64; i += 512) *(LAS f32x4*)(sv + i * 4) = *(const f32x4*)(SGV + (size_t)base * 256 + i * 4);
        __syncthreads();
        const int ch = tid & 255, h = ch >> 6, i0 = (tid >> 8) * 64;
        const float* W = a->sg_w + ((size_t)l * 4 + h) * 128 * 128; const float* bs = a->sg_b + ((size_t)l * 4 + h) * 128;
        for (int i = i0; i < i0 + 64; ++i) {
            float s = bs[i]; const float* wr = W + (size_t)i * 128;
#pragma unroll 16
            for (int j = 0; j < 128; ++j) s += wr[j] * sv[j * 256 + ch];
            bf16_t* row = P + (size_t)(base + i) * PW;
            const float u = bf2f(row[C_SU + ch]), z = bf2f(row[C_SZ + ch]);
            row[C_SU + ch] = (bf16_t)f2bf(gelu_f(u) * s * silu_f(z));
        }
    }
}
__device__ __forceinline__ void phase_gdn_prep(KA a, int l, int bid, int G) {
    const int wave = TIDX() >> 6, lane = TIDX() & 63;
    const bf16_t* P = (const bf16_t*)(a->ws + WS_P); const float* EXT = (const float*)(a->ws + WS_EXT);
    bf16_t* GQ = (bf16_t*)(a->ws + WS_GQ); bf16_t* GK = (bf16_t*)(a->ws + WS_GK); bf16_t* GV = (bf16_t*)(a->ws + WS_GV); float* GB = (float*)(a->ws + WS_GB);
    const float* cw = a->gdn_conv_w + (size_t)l * 3 * 768;
    for (int it = bid * 8 + wave; it < RT * 4; it += G * 8) {
        const int r = it >> 2, h = it & 3, chn = h * 64 + lane; const bool is_ctx = r >= RL; const int t = is_ctx ? ((r - RL) & 255) : (r & 2047), len = is_ctx ? TC : TL;
        const bf16_t* row = P + (size_t)r * PW;
        float q = 0.f, k = 0.f, v = 0.f;
#pragma unroll
        for (int d = 0; d < 3; ++d) { const int tt = t + d - 1; if (tt >= 0 && tt < len) { const bf16_t* rp = row + (ptrdiff_t)(d - 1) * PW;
            q += cw[d * 768 + chn] * bf2f(rp[C_GQ + chn]); k += cw[d * 768 + 256 + chn] * bf2f(rp[C_GK + chn]); v += cw[d * 768 + 512 + chn] * bf2f(rp[C_GV + chn]); } }
        q = silu_f(q); k = silu_f(k); v = silu_f(v);
        const float qs = rsqrtf(wave_sum(q * q) + EPS), ksn = rsqrtf(wave_sum(k * k) + EPS);
        GQ[(size_t)r * 256 + chn] = (bf16_t)f2bf(q * qs * 0.125f); GK[(size_t)r * 256 + chn] = (bf16_t)f2bf(k * ksn); GV[(size_t)r * 256 + chn] = (bf16_t)f2bf(v);
        if (lane < 4) { const int dir = lane & 1; const float e = EXT[(size_t)r * 16 + (lane >> 1) * 8 + dir * 4 + h]; float o;
            if (lane < 2) o = -__expf(a->gdn_a_log[(l * 2 + dir) * 4 + h]) * softplus_f(e + a->gdn_dt_bias[(l * 2 + dir) * 4 + h]); else o = sigmoid_f(e);
            GB[((size_t)r * 4 + h) * 4 + lane] = o; }
    }
}
__device__ __forceinline__ void phase_gdn_rec(KA a, int l, LAS unsigned char* lds, int bid, int G) {
    const int wave = TIDX() >> 6, lane = TIDX() & 63;
    const bf16_t* GQ = (const bf16_t*)(a->ws + WS_GQ); const bf16_t* GK = (const bf16_t*)(a->ws + WS_GK); const bf16_t* GV = (const bf16_t*)(a->ws + WS_GV); const float* GB = (const float*)(a->ws + WS_GB);
    float* OG = (float*)(a->ws + WS_OG);
    LAS float* qk = (LAS float*)lds + wave * 128;
    for (int ch = bid * 8 + wave; ch < NB * 4 * 2; ch += G * 8) {
        const int b = ch >> 3, h = (ch >> 1) & 3, dir = ch & 1;
        float S[64];
#pragma unroll
        for (int d = 0; d < 64; ++d) S[d] = 0.f;
        float* og = OG + (size_t)dir * RT * 256;
        auto sidx = [&](int i) { return dir == 0 ? i : (i < TC ? TC - 1 - i : (TC + TL - 1) - (i - TC)); };
        int r = seq_row(b, sidx(0));
        float qn = bf2f(GQ[(size_t)r * 256 + h * 64 + lane]), kn = bf2f(GK[(size_t)r * 256 + h * 64 + lane]), vn = bf2f(GV[(size_t)r * 256 + h * 64 + lane]);
        float gn = GB[((size_t)r * 4 + h) * 4 + dir], bn = GB[((size_t)r * 4 + h) * 4 + 2 + dir];
        for (int i = 0; i < TC + TL; ++i) {
            const float q = qn, k = kn, v = vn, g = gn, be = bn; const int rc = r;
            if (i + 1 < TC + TL) { r = seq_row(b, sidx(i + 1));
                qn = bf2f(GQ[(size_t)r * 256 + h * 64 + lane]); kn = bf2f(GK[(size_t)r * 256 + h * 64 + lane]); vn = bf2f(GV[(size_t)r * 256 + h * 64 + lane]);
                gn = GB[((size_t)r * 4 + h) * 4 + dir]; bn = GB[((size_t)r * 4 + h) * 4 + 2 + dir]; }
            qk[lane] = q; qk[64 + lane] = k;
            asm volatile("s_waitcnt lgkmcnt(0)" ::: "memory");
            const float dec = __expf(g); float kS = 0.f;
#pragma unroll
            for (int d4 = 0; d4 < 16; ++d4) { const f32x4 k4 = *(const LAS f32x4*)(qk + 64 + d4 * 4);
#pragma unroll
                for (int e = 0; e < 4; ++e) { S[d4 * 4 + e] *= dec; kS += k4[e] * S[d4 * 4 + e]; } }
            const float delta = be * (v - kS); float o = 0.f;
#pragma unroll
            for (int d4 = 0; d4 < 16; ++d4) { const f32x4 k4 = *(const LAS f32x4*)(qk + 64 + d4 * 4), q4 = *(const LAS f32x4*)(qk + d4 * 4);
#pragma unroll
                for (int e = 0; e < 4; ++e) { S[d4 * 4 + e] += k4[e] * delta; o += q4[e] * S[d4 * 4 + e]; } }
            og[(size_t)rc * 256 + h * 64 + lane] = o;
            asm volatile("s_waitcnt lgkmcnt(0)" ::: "memory");
        }
    }
}
__device__ __forceinline__ void phase_gdn_fin(KA a, int l, int bid, int G) {
    const int wave = TIDX() >> 6, lane = TIDX() & 63;
    bf16_t* P = (bf16_t*)(a->ws + WS_P); const float* OG = (const float*)(a->ws + WS_OG);
    const int nrows = (l == DEPTH - 1) ? RL : RT; const float ng = a->gdn_norm_g[l * 64 + lane];
    for (int it = bid * 8 + wave; it < nrows * 4; it += G * 8) {
        const int r = it >> 2, h = it & 3; const size_t oi = (size_t)r * 256 + h * 64 + lane;
        const float o = OG[oi] + OG[(size_t)RT * 256 + oi];
        const float rs = rsqrtf(wave_sum(o * o) * (1.f / 64.f) + EPS);
        bf16_t* zp = P + (size_t)r * PW + C_GZ + h * 64 + lane;
        *zp = (bf16_t)f2bf(o * rs * ng * silu_f(bf2f(*zp)));
    }
}
__device__ __forceinline__ void phase_ret_rec(KA a, int l, LAS unsigned char* lds, int bid, int G) {
    const int wave = TIDX() >> 6, lane = TIDX() & 63;
    const bf16_t* P = (const bf16_t*)(a->ws + WS_P); float* RO = (float*)(a->ws + WS_OG); const float* rope = (const float*)(a->ws + WS_ROPE);
    LAS float* qk = (LAS float*)lds + wave * 128;
    for (int ch = bid * 8 + wave; ch < NB * 4 * 2; ch += G * 8) {
        const int b = ch >> 3, h = (ch >> 1) & 3, dir = ch & 1;
        const float gamma = 1.f - exp2f(-5.f - (float)h);
        float S[64];
#pragma unroll
        for (int d = 0; d < 64; ++d) S[d] = 0.f;
        float* ro = RO + (size_t)dir * RT * 256;
        auto sidx = [&](int i) { return dir == 0 ? i : (i < TC ? TC - 1 - i : (TC + TL - 1) - (i - TC)); };
        const int f = lane & 15; const bool hi = (lane & 16) != 0, colhalf = lane >= 32;
        int s = sidx(0), r = seq_row(b, s);
        float qn = bf2f(P[(size_t)r * PW + C_RQ + h * 64 + lane]), kn = bf2f(P[(size_t)r * PW + C_RK + h * 64 + lane]), vn = bf2f(P[(size_t)r * PW + C_RV + h * 64 + lane]);
        for (int i = 0; i < TC + TL; ++i) {
            float q = qn, k = kn; const float v = vn; const int rc = r, sc = s;
            if (i + 1 < TC + TL) { s = sidx(i + 1); r = seq_row(b, s);
                qn = bf2f(P[(size_t)r * PW + C_RQ + h * 64 + lane]); kn = bf2f(P[(size_t)r * PW + C_RK + h * 64 + lane]); vn = bf2f(P[(size_t)r * PW + C_RV + h * 64 + lane]); }
            if (sc >= TC) { const int t = sc - TC, pos = colhalf ? (t & 63) : (t >> 6); const float cs = rope[pos * 16 + f], sn = rope[1024 + pos * 16 + f];
                const float qp = __shfl_xor(q, 16), kp = __shfl_xor(k, 16);
                q = hi ? (qp * sn + q * cs) : (q * cs - qp * sn); k = hi ? (kp * sn + k * cs) : (k * cs - kp * sn); }
            k *= 0.125f;
            qk[lane] = q; qk[64 + lane] = k;
            asm volatile("s_waitcnt lgkmcnt(0)" ::: "memory");
            float o = 0.f;
#pragma unroll
            for (int d4 = 0; d4 < 16; ++d4) { const f32x4 k4 = *(const LAS f32x4*)(qk + 64 + d4 * 4), q4 = *(const LAS f32x4*)(qk + d4 * 4);
#pragma unroll
                for (int e = 0; e < 4; ++e) { S[d4 * 4 + e] = gamma * S[d4 * 4 + e] + k4[e] * v; o += q4[e] * S[d4 * 4 + e]; } }
            ro[(size_t)rc * 256 + h * 64 + lane] = o;
            asm volatile("s_waitcnt lgkmcnt(0)" ::: "memory");
        }
    }
}
__device__ __forceinline__ void phase_ret_fin(KA a, int l, int bid, int G) {
    const int wave = TIDX() >> 6, lane = TIDX() & 63;
    bf16_t* P = (bf16_t*)(a->ws + WS_P); const float* RO = (const float*)(a->ws + WS_OG);
    const int nrows = (l == DEPTH - 1) ? RL : RT;
    for (int it = bid * 8 + wave; it < nrows * 4; it += G * 8) {
        const int r = it >> 2, h = it & 3; const size_t oi = (size_t)r * 256 + h * 64 + lane;
        float o = RO[oi] + RO[(size_t)RT * 256 + oi];
        const float mu = wave_sum(o) * (1.f / 64.f); o -= mu;
        const float rs = rsqrtf(wave_sum(o * o) * (1.f / 64.f) + EPS);
        const float z = bf2f(P[(size_t)r * PW + C_RZ + h * 64 + lane]);
        P[(size_t)r * PW + C_RQ + h * 64 + lane] = (bf16_t)f2bf(o * rs * a->ret_norm_g[l * 256 + h * 64 + lane] * silu_f(z));
    }
}

__device__ __forceinline__ void unpack8(const u32x4 w, float* o) {
#pragma unroll
    for (int e = 0; e < 4; ++e) { o[2 * e] = bf2f(w[e] & 0xffffu); o[2 * e + 1] = bf2f(w[e] >> 16); }
}
__device__ __forceinline__ void rot8(const bf16_t* hrow, int g, bool rot, int t, const float* rope, float* out) {
    const u32x4 wo = *(const u32x4*)(hrow + 8 * g), wp = *(const u32x4*)(hrow + 8 * (g ^ 2));
    const int tt = t & 2047, pos = (g >> 2) ? (tt & 63) : (tt >> 6), f0 = 8 * (g & 1); const bool hi = (g & 2) != 0;
    const f32x4 c0 = *(const f32x4*)(rope + pos * 16 + f0), c1 = *(const f32x4*)(rope + pos * 16 + f0 + 4), s0 = *(const f32x4*)(rope + 1024 + pos * 16 + f0), s1 = *(const f32x4*)(rope + 1024 + pos * 16 + f0 + 4);
    float p[8]; unpack8(wo, out); unpack8(wp, p);
#pragma unroll
    for (int j = 0; j < 8; ++j) { const float cs = j < 4 ? c0[j & 3] : c1[j & 3], sn = j < 4 ? s0[j & 3] : s1[j & 3]; const float rv = hi ? (p[j] * sn + out[j] * cs) : (out[j] * cs - p[j] * sn); out[j] = rot ? rv : out[j]; }
}
__device__ __forceinline__ int ret_row0(int b, int c) { return c < 2 ? RL + b * TC + c * 128 : b * TL + (c - 2) * 128; }
constexpr int TS = 272, RS = 144;

__device__ __forceinline__ void phase_ret_kv(KA a, int l, LAS unsigned char* lds, int bid, int G) {
    const int tid = TIDX(), wave = tid >> 6, lane = tid & 63, fr = lane & 15, fq = lane >> 4;
    const bf16_t* P = (const bf16_t*)(a->ws + WS_P); const float* rope = (const float*)(a->ws + WS_ROPE); bf16_t* KV = (bf16_t*)(a->ws + WS_KV);
    LAS unsigned char* kTf = lds; LAS unsigned char* kTb = lds + 64 * TS; LAS unsigned char* vT = lds + 128 * TS;
    for (int u = G - 1 - bid; u < NB * 18 * 4; u += G) {
        const int h = u & 3, c = (u >> 2) % 18, b = (u >> 2) / 18, row0 = ret_row0(b, c); const bool rot = c >= 2;
        const float lg = log2f(1.f - exp2f(-5.f - (float)h));
        __syncthreads();
        { const int g = wave, pp = lane, p0 = 2 * pp;
          float k0[8], k1[8], v0[8], v1[8];
          const bf16_t* r0 = P + (size_t)(row0 + p0) * PW + h * 64; const bf16_t* r1 = r0 + PW;
          rot8(r0 + C_RK, g, rot, (c - 2) * 128 + p0, rope, k0); rot8(r1 + C_RK, g, rot, (c - 2) * 128 + p0 + 1, rope, k1);
          unpack8(*(const u32x4*)(r0 + C_RV + 8 * g), v0); unpack8(*(const u32x4*)(r1 + C_RV + 8 * g), v1);
          const float wf0 = 0.125f * exp2f(lg * (float)(127 - p0)), wf1 = 0.125f * exp2f(lg * (float)(126 - p0)), wb0 = 0.125f * exp2f(lg * (float)p0), wb1 = 0.125f * exp2f(lg * (float)(p0 + 1));
#pragma unroll
          for (int j = 0; j < 8; ++j) { const int d = 8 * g + j;
              *(LAS unsigned*)(kTf + d * TS + pp * 4) = cvt_pk_bf16(k0[j] * wf0, k1[j] * wf1);
              *(LAS unsigned*)(kTb + d * TS + pp * 4) = cvt_pk_bf16(k0[j] * wb0, k1[j] * wb1);
              *(LAS unsigned*)(vT + d * TS + pp * 4) = cvt_pk_bf16(v0[j], v1[j]); } }
        __syncthreads();
        { const int dir = wave >> 2, mt = wave & 3; LAS unsigned char* kT = dir ? kTb : kTf;
          bf16x8 af[4];
#pragma unroll
          for (int ks = 0; ks < 4; ++ks) af[ks] = *(const LAS bf16x8*)(kT + (16 * mt + fr) * TS + (ks * 32 + fq * 8) * 2);
          bf16_t* dst = KV + ((size_t)u * 2 + dir) * 4096;
#pragma unroll
          for (int nt = 0; nt < 4; ++nt) { f32x4 acc = (f32x4){0.f, 0.f, 0.f, 0.f};
#pragma unroll
              for (int ks = 0; ks < 4; ++ks) { const bf16x8 bfr = *(const LAS bf16x8*)(vT + (16 * nt + fr) * TS + (ks * 32 + fq * 8) * 2); acc = __builtin_amdgcn_mfma_f32_16x16x32_bf16(af[ks], bfr, acc, 0, 0, 0); }
              u32x2 w; w.x = cvt_pk_bf16(acc[0], acc[1]); w.y = cvt_pk_bf16(acc[2], acc[3]);
              *(u32x2*)(dst + (16 * nt + fr) * 64 + 16 * mt + fq * 4) = w; } }
    }
}
__device__ __forceinline__ void phase_ret_out(KA a, int l, LAS unsigned char* lds, int bid, int G, int u_lo, int u_hi, bool st = true) {
    const int tid = TIDX(), wave = tid >> 6, lane = tid & 63, fr = lane & 15, fq = lane >> 4;
    bf16_t* P = (bf16_t*)(a->ws + WS_P); const float* rope = (const float*)(a->ws + WS_ROPE); const bf16_t* KV = (const bf16_t*)(a->ws + WS_KV);
    LAS unsigned char* qL = lds; LAS unsigned char* kL = lds + 128 * RS; LAS unsigned char* vT = lds + 256 * RS; LAS unsigned char* sF = vT + 64 * TS; LAS unsigned char* sB = sF + 64 * RS;
    LAS float* oL = (LAS float*)(sB + 64 * RS) + wave * (16 * 68);
    const int c_lo = (l == DEPTH - 1) ? 2 : 0, ncu = 18 - c_lo;
    for (int u = u_lo + bid; u < u_hi; u += G) {
        const int h = u & 3, c = c_lo + (u >> 2) % ncu, b = (u >> 2) / ncu, row0 = ret_row0(b, c); const bool rot = c >= 2;
        const float lg = log2f(1.f - exp2f(-5.f - (float)h));
        __syncthreads();
#pragma unroll
        for (int it = 0; it < 2; ++it) { const int item = tid + it * 512, p = item >> 3, g = item & 7; float q8[8], k8[8];
            const bf16_t* rp = P + (size_t)(row0 + p) * PW + h * 64;
            rot8(rp + C_RQ, g, rot, (c - 2) * 128 + p, rope, q8); rot8(rp + C_RK, g, rot, (c - 2) * 128 + p, rope, k8);
            u32x4 w; w.x = cvt_pk_bf16(q8[0], q8[1]); w.y = cvt_pk_bf16(q8[2], q8[3]); w.z = cvt_pk_bf16(q8[4], q8[5]); w.w = cvt_pk_bf16(q8[6], q8[7]);
            *(LAS u32x4*)(qL + p * RS + g * 16) = w;
            w.x = cvt_pk_bf16(k8[0] * 0.125f, k8[1] * 0.125f); w.y = cvt_pk_bf16(k8[2] * 0.125f, k8[3] * 0.125f); w.z = cvt_pk_bf16(k8[4] * 0.125f, k8[5] * 0.125f); w.w = cvt_pk_bf16(k8[6] * 0.125f, k8[7] * 0.125f);
            *(LAS u32x4*)(kL + p * RS + g * 16) = w; }
        { const int g = wave, pp = lane; const bf16_t* r0 = P + (size_t)(row0 + 2 * pp) * PW + C_RV + h * 64 + 8 * g;
          const u32x4 w0 = *(const u32x4*)r0, w1 = *(const u32x4*)(r0 + PW);
#pragma unroll
          for (int j = 0; j < 8; ++j) { const unsigned lo = (j & 1) ? (w0[j >> 1] >> 16) : (w0[j >> 1] & 0xffffu), hi2 = (j & 1) ? (w1[j >> 1] >> 16) : (w1[j >> 1] & 0xffffu);
              *(LAS unsigned*)(vT + (8 * g + j) * TS + pp * 4) = lo | (hi2 << 16); } }
        u32x4 zpre[2];
#pragma unroll
        for (int it = 0; it < 2; ++it) { const int item = lane + 64 * it; zpre[it] = *(const u32x4*)(P + (size_t)(row0 + 16 * wave + (item >> 3)) * PW + h * 64 + 8 * (item & 7) + C_RZ); }
        { const int e = tid >> 3, d0 = (tid & 7) * 8; const float lc = lg * 128.f;
          float sf[8], sb[8];
#pragma unroll
          for (int j = 0; j < 8; ++j) { sf[j] = 0.f; sb[j] = 0.f; }
          const int obc = c < 2 ? 1 - c : 19 - c;
          const bf16_t* kvb = KV + ((size_t)((b * 18) * 4 + h) * 2) * 4096 + e * 64 + d0;
#pragma unroll 1
          for (int jb = 0; jb < 18; jb += 6) { u32x4 tf[6], tb[6];
#pragma unroll
              for (int jj = 0; jj < 6; ++jj) { tf[jj] = *(const u32x4*)(kvb + (size_t)(jb + jj) * 32768); tb[jj] = *(const u32x4*)(kvb + (size_t)(jb + jj) * 32768 + 4096); }
#pragma unroll
              for (int jj = 0; jj < 6; ++jj) { const int j = jb + jj, obj = j < 2 ? 1 - j : 19 - j;
                  const float wf = j < c ? exp2f(lc * (float)(c - 1 - j)) : 0.f, wb = obj < obc ? exp2f(lc * (float)(obc - 1 - obj)) : 0.f;
                  float t8[8]; unpack8(tf[jj], t8);
#pragma unroll
                  for (int x = 0; x < 8; ++x) sf[x] += wf * t8[x];
                  unpack8(tb[jj], t8);
#pragma unroll
                  for (int x = 0; x < 8; ++x) sb[x] += wb * t8[x]; } }
          u32x4 w; w.x = cvt_pk_bf16(sf[0], sf[1]); w.y = cvt_pk_bf16(sf[2], sf[3]); w.z = cvt_pk_bf16(sf[4], sf[5]); w.w = cvt_pk_bf16(sf[6], sf[7]);
          *(LAS u32x4*)(sF + e * RS + d0 * 2) = w;
          w.x = cvt_pk_bf16(sb[0], sb[1]); w.y = cvt_pk_bf16(sb[2], sb[3]); w.z = cvt_pk_bf16(sb[4], sb[5]); w.w = cvt_pk_bf16(sb[6], sb[7]);
          *(LAS u32x4*)(sB + e * RS + d0 * 2) = w; }
        __syncthreads();
        const int i0 = 16 * wave;
        bf16x8 qf[2];
#pragma unroll
        for (int ks = 0; ks < 2; ++ks) qf[ks] = *(const LAS bf16x8*)(qL + (i0 + fr) * RS + (ks * 32 + fq * 8) * 2);
        bf16x8 pf[4];
#pragma unroll
        for (int t = 0; t < 4; ++t) { f32x4 s2[2];
#pragma unroll
            for (int hh = 0; hh < 2; ++hh) { const int jt = 2 * t + hh; f32x4 acc = (f32x4){0.f, 0.f, 0.f, 0.f};
#pragma unroll
                for (int ks = 0; ks < 2; ++ks) { const bf16x8 kf = *(const LAS bf16x8*)(kL + (16 * jt + fr) * RS + (ks * 32 + fq * 8) * 2); acc = __builtin_amdgcn_mfma_f32_16x16x32_bf16(kf, qf[ks], acc, 0, 0, 0); }
#pragma unroll
                for (int r = 0; r < 4; ++r) { const int jj = 16 * jt + 4 * fq + r, ii = i0 + fr, df = ii > jj ? ii - jj : jj - ii; acc[r] *= exp2f(lg * (float)df) * (df == 0 ? 2.f : 1.f); }
                s2[hh] = acc; }
            u32x4 w; w.x = cvt_pk_bf16(s2[0][0], s2[0][1]); w.y = cvt_pk_bf16(s2[0][2], s2[0][3]); w.z = cvt_pk_bf16(s2[1][0], s2[1][1]); w.w = cvt_pk_bf16(s2[1][2], s2[1][3]);
            pf[t] = __builtin_bit_cast(bf16x8, w); }
        float dq[4], db[4];
#pragma unroll
        for (int r = 0; r < 4; ++r) { const int pi = i0 + 4 * fq + r; dq[r] = exp2f(lg * (float)(pi + 1)); db[r] = exp2f(lg * (float)(128 - pi)); }
        f32x4 o[4]; float sum[4] = {0.f, 0.f, 0.f, 0.f};
#pragma unroll
        for (int nt = 0; nt < 4; ++nt) { f32x4 acc = (f32x4){0.f, 0.f, 0.f, 0.f}, af = acc, ab = acc;
#pragma unroll
            for (int t = 0; t < 4; ++t) { const LAS unsigned char* vp = vT + (16 * nt + fr) * TS + (32 * t + 4 * fq) * 2;
                const u32x2 lo = *(const LAS u32x2*)vp, hi2 = *(const LAS u32x2*)(vp + 32); const u32x4 w = (u32x4){lo.x, lo.y, hi2.x, hi2.y};
                acc = __builtin_amdgcn_mfma_f32_16x16x32_bf16(pf[t], __builtin_bit_cast(bf16x8, w), acc, 0, 0, 0); }
#pragma unroll
            for (int ks = 0; ks < 2; ++ks) { const bf16x8 s1 = *(const LAS bf16x8*)(sF + (16 * nt + fr) * RS + (ks * 32 + fq * 8) * 2), s2 = *(const LAS bf16x8*)(sB + (16 * nt + fr) * RS + (ks * 32 + fq * 8) * 2);
                af = __builtin_amdgcn_mfma_f32_16x16x32_bf16(qf[ks], s1, af, 0, 0, 0); ab = __builtin_amdgcn_mfma_f32_16x16x32_bf16(qf[ks], s2, ab, 0, 0, 0); }
#pragma unroll
            for (int r = 0; r < 4; ++r) { acc[r] += af[r] * dq[r] + ab[r] * db[r]; sum[r] += acc[r]; }
            o[nt] = acc; }
        float mu[4], rs[4];
#pragma unroll
        for (int r = 0; r < 4; ++r) { float sv = sum[r]; sv += __shfl_xor(sv, 1); sv += __shfl_xor(sv, 2); sv += __shfl_xor(sv, 4); sv += __shfl_xor(sv, 8); mu[r] = sv * (1.f / 64.f);
            float q2 = 0.f;
#pragma unroll
            for (int nt = 0; nt < 4; ++nt) { const float dd = o[nt][r] - mu[r]; q2 += dd * dd; }
            q2 += __shfl_xor(q2, 1); q2 += __shfl_xor(q2, 2); q2 += __shfl_xor(q2, 4); q2 += __shfl_xor(q2, 8); rs[r] = rsqrtf(q2 * (1.f / 64.f) + EPS); }
#pragma unroll
        for (int nt = 0; nt < 4; ++nt)
#pragma unroll
            for (int r = 0; r < 4; ++r) oL[(4 * fq + r) * 68 + 16 * nt + fr] = (o[nt][r] - mu[r]) * rs[r];
        __syncthreads();
#pragma unroll
        for (int it = 0; it < 2; ++it) { const int item = lane + 64 * it, rr = item >> 3, g = item & 7;
            const f32x4 x0 = *(const LAS f32x4*)(oL + rr * 68 + 8 * g), x1 = *(const LAS f32x4*)(oL + rr * 68 + 8 * g + 4);
            bf16_t* rp = P + (size_t)(row0 + i0 + rr) * PW + h * 64 + 8 * g; float z8[8]; unpack8(zpre[it], z8);
            const float* ng = a->ret_norm_g + l * 256 + h * 64 + 8 * g; const f32x4 g0 = *(const f32x4*)ng, g1 = *(const f32x4*)(ng + 4);
            float y[8];
#pragma unroll
            for (int j = 0; j < 8; ++j) y[j] = (j < 4 ? x0[j & 3] * g0[j & 3] : x1[j & 3] * g1[j & 3]) * silu_f(z8[j]);
            u32x4 w; w.x = cvt_pk_bf16(y[0], y[1]); w.y = cvt_pk_bf16(y[2], y[3]); w.z = cvt_pk_bf16(y[4], y[5]); w.w = cvt_pk_bf16(y[6], y[7]);
#if EXP_NOINPLACE
            *(u32x4*)((bf16_t*)(a->ws + WS_OG) + (size_t)(row0 + i0 + rr) * 256 + h * 64 + 8 * g) = w; }
#else
            if (st) *(u32x4*)(rp + C_RQ) = w; }
#endif
    }
}
__device__ __forceinline__ void phase_ret_copy(KA a, int l, int bid, int G) {
    bf16_t* P = (bf16_t*)(a->ws + WS_P); const bf16_t* Y = (const bf16_t*)(a->ws + WS_OG);
    const int nrows = (l == DEPTH - 1) ? RL : RT;
    for (int it = bid * 512 + TIDX(); it < nrows * 32; it += G * 512) { const int r = it >> 5, c8 = (it & 31) * 8;
        *(u32x4*)(P + (size_t)r * PW + C_RQ + c8) = *(const u32x4*)(Y + (size_t)r * 256 + c8); }
}

constexpr size_t WS_QN = WS_X, WS_KN = WS_X + 18 * MiB, WS_KNT = WS_X + 36 * MiB, WS_WN = WS_X + 54 * MiB, WS_UT = WS_X + 90 * MiB, WS_SOLD0 = WS_X + 126 * MiB,
                 WS_SOLD1 = 492 * MiB, WS_GC = 510 * MiB, WS_END2 = 512 * MiB;
__device__ __forceinline__ int P32(int c) { return ((c & 15) >> 2) * 8 + (c >> 4) * 4 + (c & 3); }
__device__ __forceinline__ int gdn_row0(int b, int c) { return c < 4 ? RL + b * TC + c * 64 : b * TL + (c - 4) * 64; }
__device__ __forceinline__ u32x4 pack8(const float* v) { u32x4 w; w.x = cvt_pk_bf16(v[0], v[1]); w.y = cvt_pk_bf16(v[2], v[3]); w.z = cvt_pk_bf16(v[4], v[5]); w.w = cvt_pk_bf16(v[6], v[7]); return w; }

template <int DIR>
__device__ __forceinline__ void gdn_solve(int lane, int hd, int half, int gub, LAS unsigned char* knL, LAS float* vL, LAS float* Lm, LAS float* DinvL, LAS float* btL, LAS float* egL, bf16_t* UT, bf16_t* WN) {
    const int hh = hd >> 1, fr = lane & 15, fq = lane >> 4;
    const int i0 = DIR ? 12 - 4 * fq : 4 * fq;
    auto ioff = [](int kb, int r) { return DIR ? 16 * (3 - kb) + (3 - r) : 16 * kb + r; };
    const LAS float* Lb = Lm + (hd * 64 + fr) * 64 + 4 * fq; const LAS float* bb = btL + hd * 64 + i0; const LAS float* eb = egL + hd * 64 + i0;
    const LAS float* vb = vL + (hh * 64 + i0) * 64 + fr; const LAS unsigned char* kb_ = knL + (hh * 64 + i0) * 144 + fr * 2;
    const LAS float* Db = DinvL + (hd * 64 + fr) * 16 + 4 * fq;
    f32x4 X[4][4];
#pragma unroll
    for (int kb = 0; kb < 4; ++kb) {
        f32x4 acc[4];
#pragma unroll
        for (int r = 0; r < 4; ++r) { const int io = ioff(kb, r); const float bt = bb[io], be = bt * eb[io];
#pragma unroll
            for (int nt = 0; nt < 4; ++nt) acc[nt][r] = half == 0 ? vb[io * 64 + 16 * nt] * bt : bf2f(*(const LAS bf16_t*)(kb_ + io * 144 + 32 * nt)) * be; }
#pragma unroll
        for (int m = 0; m < kb; ++m) { const f32x4 a4 = *(const LAS f32x4*)(Lb + (16 * kb) * 64 + 16 * m);
#pragma unroll
            for (int r = 0; r < 4; ++r)
#pragma unroll
                for (int nt = 0; nt < 4; ++nt) acc[nt] = __builtin_amdgcn_mfma_f32_16x16x4f32(-a4[r], X[m][nt][r], acc[nt], 0, 0, 0); }
        const f32x4 d4 = *(const LAS f32x4*)(Db + kb * 256);
#pragma unroll
        for (int nt = 0; nt < 4; ++nt) { f32x4 x = (f32x4){0.f, 0.f, 0.f, 0.f};
#pragma unroll
            for (int r = 0; r < 4; ++r) x = __builtin_amdgcn_mfma_f32_16x16x4f32(d4[r], acc[nt][r], x, 0, 0, 0);
            X[kb][nt] = x; } }
    const size_t gu2 = (size_t)(gub + hh) * 2 + DIR;
    if (half == 0) { bf16_t* dst = UT + gu2 * 4096 + (size_t)fr * 64 + i0 - (DIR ? 3 : 0) + (DIR ? 3 : 0);
#pragma unroll
        for (int kb = 0; kb < 4; ++kb)
#pragma unroll
            for (int nt = 0; nt < 4; ++nt) { const f32x4 x = X[kb][nt]; u32x2 w;
                if (DIR == 0) { w.x = cvt_pk_bf16(x[0], x[1]); w.y = cvt_pk_bf16(x[2], x[3]); } else { w.x = cvt_pk_bf16(x[3], x[2]); w.y = cvt_pk_bf16(x[1], x[0]); }
                *(u32x2*)(dst + nt * 1024 + (DIR ? 16 * (3 - kb) : 16 * kb)) = w; } }
    else { bf16_t* dst = WN + gu2 * 4096 + (size_t)i0 * 64 + (fr >> 2) * 8 + (fr & 3);
#pragma unroll
        for (int kb = 0; kb < 4; ++kb)
#pragma unroll
            for (int nt = 0; nt < 4; ++nt)
#pragma unroll
                for (int r = 0; r < 4; ++r) dst[ioff(kb, r) * 64 + 32 * (nt >> 1) + 4 * (nt & 1)] = (bf16_t)f2bf(-X[kb][nt][r]); }
}
__device__ __forceinline__ void phase_gdn_prep2(KA a, int l, LAS unsigned char* lds, int bid, int G) {
    const int tid = TIDX(), wave = tid >> 6, lane = tid & 63, fr = lane & 15, fq = lane >> 4;
    unsigned char* ws = a->ws; const bf16_t* P = (const bf16_t*)(ws + WS_P); const float* EXT = (const float*)(ws + WS_EXT);
    bf16_t* QN = (bf16_t*)(ws + WS_QN); bf16_t* KN = (bf16_t*)(ws + WS_KN); bf16_t* KNT = (bf16_t*)(ws + WS_KNT); bf16_t* WN = (bf16_t*)(ws + WS_WN); bf16_t* UT = (bf16_t*)(ws + WS_UT); float* GC = (float*)(ws + WS_GC);
    LAS unsigned char* knL = lds;
    LAS float* vL = (LAS float*)(lds + 18432);
    LAS float* Lm = (LAS float*)(lds + 51200);
    LAS float* gcL = (LAS float*)(lds + 116736); LAS float* btL = gcL + 256; LAS float* egL = gcL + 512;
    LAS float* DinvL = (LAS float*)(lds + 119808);
    const float* cw = a->gdn_conv_w + (size_t)l * 3 * 768;
    for (int u = bid; u < NB * 36 * 2; u += G) {
        const int hp = u & 1, c = (u >> 1) % 36, b = (u >> 1) / 36, row0 = gdn_row0(b, c); const bool is_ctx = c < 4;
        const int t0 = is_ctx ? c * 64 : (c - 4) * 64, len = is_ctx ? TC : TL; const int gub = ((b * 36 + c) * 4 + hp * 2);
        __syncthreads();
        {
            const int g = tid & 7, hh = (tid >> 3) & 1, h = hp * 2 + hh, chq = h * 64 + 8 * g; const int gu = gub + hh;
            float wq[3][8], wk[3][8], wv[3][8];
#pragma unroll
            for (int tap = 0; tap < 3; ++tap) { const float* cp = cw + tap * 768 + chq;
                const f32x4 a0 = *(const f32x4*)cp, a1 = *(const f32x4*)(cp + 4), b0 = *(const f32x4*)(cp + 256), b1 = *(const f32x4*)(cp + 260), c0 = *(const f32x4*)(cp + 512), c1 = *(const f32x4*)(cp + 516);
#pragma unroll
                for (int j = 0; j < 4; ++j) { wq[tap][j] = a0[j]; wq[tap][4 + j] = a1[j]; wk[tap][j] = b0[j]; wk[tap][4 + j] = b1[j]; wv[tap][j] = c0[j]; wv[tap][4 + j] = c1[j]; } }
#pragma unroll
            for (int it = 0; it < 2; ++it) { const int i = (tid >> 4) + 32 * it, t = t0 + i;
                u32x4 ldq[3], ldk[3], ldv[3]; float msk[3];
#pragma unroll
                for (int tap = 0; tap < 3; ++tap) { const int tt = t + tap - 1, tc = tt < 0 ? 0 : (tt >= len ? len - 1 : tt); msk[tap] = (tt == tc) ? 1.f : 0.f;
                    const bf16_t* rp = P + (size_t)(row0 + i + (tc - t)) * PW + chq;
                    ldq[tap] = *(const u32x4*)(rp + C_GQ); ldk[tap] = *(const u32x4*)(rp + C_GK); ldv[tap] = *(const u32x4*)(rp + C_GV); }
                float q8[8], k8[8], v8[8];
#pragma unroll
                for (int j = 0; j < 8; ++j) { q8[j] = 0.f; k8[j] = 0.f; v8[j] = 0.f; }
#pragma unroll
                for (int tap = 0; tap < 3; ++tap) { float x8[8]; const float mk = msk[tap];
                    unpack8(ldq[tap], x8);
#pragma unroll
                    for (int j = 0; j < 8; ++j) q8[j] += wq[tap][j] * mk * x8[j];
                    unpack8(ldk[tap], x8);
#pragma unroll
                    for (int j = 0; j < 8; ++j) k8[j] += wk[tap][j] * mk * x8[j];
                    unpack8(ldv[tap], x8);
#pragma unroll
                    for (int j = 0; j < 8; ++j) v8[j] += wv[tap][j] * mk * x8[j]; }
                float sq = 0.f, sk = 0.f;
#pragma unroll
                for (int j = 0; j < 8; ++j) { q8[j] = silu_f(q8[j]); k8[j] = silu_f(k8[j]); v8[j] = silu_f(v8[j]); sq += q8[j] * q8[j]; sk += k8[j] * k8[j]; }
                sq += __shfl_xor(sq, 1); sq += __shfl_xor(sq, 2); sq += __shfl_xor(sq, 4); sk += __shfl_xor(sk, 1); sk += __shfl_xor(sk, 2); sk += __shfl_xor(sk, 4);
                const float rq = rsqrtf(sq + EPS) * 0.125f, rk = rsqrtf(sk + EPS);
#pragma unroll
                for (int j = 0; j < 8; ++j) { q8[j] *= rq; k8[j] *= rk; }
                *(u32x4*)(QN + ((size_t)gu * 64 + i) * 64 + 8 * g) = pack8(q8);
                const u32x4 kw = pack8(k8);
                *(u32x4*)(KN + ((size_t)gu * 64 + i) * 64 + 8 * g) = kw;
                *(LAS u32x4*)(knL + (hh * 64 + i) * 144 + g * 16) = kw;
                *(LAS f32x4*)(vL + (hh * 64 + i) * 64 + 8 * g) = (f32x4){v8[0], v8[1], v8[2], v8[3]}; *(LAS f32x4*)(vL + (hh * 64 + i) * 64 + 8 * g + 4) = (f32x4){v8[4], v8[5], v8[6], v8[7]}; }
        }
        if (wave < 4) {
            const int hh = wave >> 1, dir = wave & 1, h = hp * 2 + hh, i = lane; const size_t row = (size_t)(row0 + i);
            const float av = EXT[row * 16 + dir * 4 + h], bv = EXT[row * 16 + 8 + dir * 4 + h];
            float gcum = -__expf(a->gdn_a_log[(l * 2 + dir) * 4 + h]) * softplus_f(av + a->gdn_dt_bias[(l * 2 + dir) * 4 + h]);
#pragma unroll
            for (int o = 1; o < 64; o <<= 1) { const float up = __shfl_up(gcum, o), dn = __shfl_down(gcum, o); if (dir == 0) { if (lane >= o) gcum += up; } else { if (lane + o < 64) gcum += dn; } }
            gcL[wave * 64 + i] = gcum; btL[wave * 64 + i] = sigmoid_f(bv); egL[wave * 64 + i] = __expf(gcum);
            GC[((size_t)(gub + hh) * 2 + dir) * 64 + i] = gcum;
        }
        __syncthreads();
        {
            const int hh = wave >> 2, it_ = wave & 3; LAS unsigned char* kb = knL + hh * 64 * 144;
            bf16x8 af[2];
#pragma unroll
            for (int ks = 0; ks < 2; ++ks) af[ks] = *(const LAS bf16x8*)(kb + (16 * it_ + fr) * 144 + (ks * 32 + fq * 8) * 2);
#pragma unroll
            for (int jt = 0; jt < 4; ++jt) { f32x4 acc = (f32x4){0.f, 0.f, 0.f, 0.f};
#pragma unroll
                for (int ks = 0; ks < 2; ++ks) { const bf16x8 bfr = *(const LAS bf16x8*)(kb + (16 * jt + fr) * 144 + (ks * 32 + fq * 8) * 2); acc = __builtin_amdgcn_mfma_f32_16x16x32_bf16(af[ks], bfr, acc, 0, 0, 0); }
                const int j = 16 * jt + fr;
#pragma unroll
                for (int dir = 0; dir < 2; ++dir) { const int hd = hh * 2 + dir; const float gj = gcL[hd * 64 + j];
#pragma unroll
                    for (int r = 0; r < 4; ++r) { const int i = 16 * it_ + 4 * fq + r; const bool valid = dir ? (i < j) : (i > j);
                        const float val = valid ? btL[hd * 64 + i] * acc[r] * __expf(gcL[hd * 64 + i] - gj) : 0.f;
                        const int p = dir ? 63 - i : i, q = dir ? 63 - j : j; Lm[(hd * 64 + p) * 64 + q] = val; } } }
#pragma unroll
            for (int it2 = 0; it2 < 2; ++it2) { const int item = tid + 512 * it2, hh2 = item >> 9, d = (item >> 3) & 63, tg = item & 7; float t8[8];
#pragma unroll
                for (int x = 0; x < 8; ++x) t8[x] = bf2f(*(const LAS bf16_t*)(knL + (hh2 * 64 + 8 * tg + x) * 144 + d * 2));
                const u32x4 kw2 = pack8(t8); bf16_t* kd = KNT + ((size_t)(gub + hh2) * 64 + d) * 64 + ((8 * tg) & 32) + P32((8 * tg) & 31);
                *(u32x2*)kd = (u32x2){kw2.x, kw2.y}; *(u32x2*)(kd + 8) = (u32x2){kw2.z, kw2.w}; }
        }
        __syncthreads();
        {
            if (tid < 256) { const int hd = tid >> 6, kb = (tid >> 4) & 3, cidx = tid & 15; const LAS float* Dg = Lm + (hd * 64 + 16 * kb) * 64 + 16 * kb;
                float y[16];
#pragma unroll
                for (int r = 0; r < 16; ++r) y[r] = 0.f;
#pragma unroll
                for (int rb = 0; rb < 16; rb += 8) {
                    f32x4 dr[8][4];
#pragma unroll
                    for (int r = 0; r < 8; ++r)
#pragma unroll
                        for (int q4 = 0; q4 < (rb + r + 3) / 4; ++q4) dr[r][q4] = *(const LAS f32x4*)(Dg + (rb + r) * 64 + 4 * q4);
#pragma unroll
                    for (int r = 0; r < 8; ++r) { const int rr = rb + r; float acc = (rr == cidx) ? 1.f : 0.f;
#pragma unroll
                        for (int q4 = 0; q4 < (rr + 3) / 4; ++q4) acc -= dr[r][q4][0] * y[4 * q4] + dr[r][q4][1] * y[4 * q4 + 1] + dr[r][q4][2] * y[4 * q4 + 2] + dr[r][q4][3] * y[4 * q4 + 3];
                        y[rr] = acc; DinvL[((hd * 4 + kb) * 16 + rr) * 16 + cidx] = acc; } } }
        }
        __syncthreads();
        {
            const int w8 = __builtin_amdgcn_readfirstlane(tid >> 6);
            if ((w8 >> 1) & 1) gdn_solve<1>(lane, w8 >> 1, w8 & 1, gub, knL, vL, Lm, DinvL, btL, egL, UT, WN); else gdn_solve<0>(lane, w8 >> 1, w8 & 1, gub, knL, vL, Lm, DinvL, btL, egL, UT, WN);
        }
    }
}
__device__ __forceinline__ void phase_gdn_chain(KA a, int l, LAS unsigned char* lds, int bid, int G) {
    const int tid = TIDX(), wave = __builtin_amdgcn_readfirstlane(tid >> 6), lane = tid & 63, fr = lane & 15, fq = lane >> 4;
    unsigned char* ws = a->ws; const bf16_t* KNT = (const bf16_t*)(ws + WS_KNT); const bf16_t* WN = (const bf16_t*)(ws + WS_WN); bf16_t* UT = (bf16_t*)(ws + WS_UT); const float* GC = (const float*)(ws + WS_GC);
    constexpr int SLOT = 27904, OFF_KT = 9216, OFF_UT = 18432, OFF_GC = 27648, D = 5;
    for (int ch = bid; ch < NB * 8; ch += G) {
        const int b = ch >> 3, h = (ch >> 1) & 3, dir = ch & 1;
        auto chunk_of = [&](int k) { return dir == 0 ? k : (k < 4 ? 3 - k : 39 - k); };
        __syncthreads();
        if (wave >= 4) {
            const int t = tid - 256;
            u32x4 st[6][6]; f32x4 sgc[6];
            auto issue = [&](int s_, int set) { const int c = chunk_of(s_); const size_t gu = (size_t)((b * 36 + c) * 4 + h), gu2 = gu * 2 + dir;
#pragma unroll
                for (int i = 0; i < 2; ++i) { const int q = t + 256 * i; st[set][i] = *(const u32x4*)(WN + gu2 * 4096 + q * 8); st[set][2 + i] = *(const u32x4*)(KNT + gu * 4096 + q * 8); st[set][4 + i] = *(const u32x4*)(UT + gu2 * 4096 + q * 8); }
                if (t < 16) sgc[set] = *(const f32x4*)(GC + gu2 * 64 + 4 * t); };
            auto put = [&](int s_, int set) { LAS unsigned char* sl = lds + (s_ & 1) * SLOT;
#pragma unroll
                for (int i = 0; i < 2; ++i) { const int q = t + 256 * i, off = (q >> 3) * 144 + (q & 7) * 16; *(LAS u32x4*)(sl + off) = st[set][i]; *(LAS u32x4*)(sl + OFF_KT + off) = st[set][2 + i]; *(LAS u32x4*)(sl + OFF_UT + off) = st[set][4 + i]; }
                if (t < 16) *(LAS f32x4*)(sl + OFF_GC + 16 * t) = sgc[set]; };
#pragma unroll
            for (int s_ = 0; s_ < D; ++s_) issue(s_, s_);
            put(0, 0);
            __syncthreads();
            for (int kk = 0; kk < 36; kk += 6) {
#pragma unroll
                for (int j = 0; j < 6; ++j) { const int k = kk + j;
                    if (k + D < 36) issue(k + D, (j + D) % 6);
                    if (k + 1 < 36) put(k + 1, (j + 1) % 6);
                    __syncthreads(); } }
        } else {
            const int n0 = 16 * wave;
            bf16_t* SOLD = (bf16_t*)(ws + (dir ? WS_SOLD1 : WS_SOLD0));
            f32x4 Sc[4]; u32x4 Sb[2];
#pragma unroll
            for (int m = 0; m < 4; ++m) Sc[m] = (f32x4){0.f, 0.f, 0.f, 0.f};
            Sb[0] = (u32x4){0, 0, 0, 0}; Sb[1] = Sb[0];
            __syncthreads();
            for (int k = 0; k < 36; ++k) {
                const int c = chunk_of(k); const size_t gu = (size_t)((b * 36 + c) * 4 + h), gu2 = gu * 2 + dir;
                const LAS unsigned char* sl = lds + (k & 1) * SLOT;
                u32x4 wn[4][2], kt[4][2]; u32x2 uu[4]; f32x4 gcv[2][2];
#pragma unroll
                for (int m = 0; m < 4; ++m) {
#pragma unroll
                    for (int ks = 0; ks < 2; ++ks) { wn[m][ks] = *(const LAS u32x4*)(sl + (16 * m + fr) * 144 + ks * 64 + fq * 16); kt[m][ks] = *(const LAS u32x4*)(sl + OFF_KT + (16 * m + fr) * 144 + ks * 64 + fq * 16); }
                    uu[m] = *(const LAS u32x2*)(sl + OFF_UT + (n0 + fr) * 144 + (16 * m + 4 * fq) * 2); }
#pragma unroll
                for (int ks = 0; ks < 2; ++ks) { gcv[ks][0] = *(const LAS f32x4*)(sl + OFF_GC + (32 * ks + 4 * fq) * 4); gcv[ks][1] = *(const LAS f32x4*)(sl + OFF_GC + (32 * ks + 16 + 4 * fq) * 4); }
                const float glast = *(const LAS float*)(sl + OFF_GC + (dir ? 0 : 63) * 4);
                f32x4 vn[4];
#pragma unroll
                for (int m = 0; m < 4; ++m) { f32x4 acc = (f32x4){bf2f(uu[m].x & 0xffffu), bf2f(uu[m].x >> 16), bf2f(uu[m].y & 0xffffu), bf2f(uu[m].y >> 16)};
#pragma unroll
                    for (int ks = 0; ks < 2; ++ks) acc = __builtin_amdgcn_mfma_f32_16x16x32_bf16(__builtin_bit_cast(bf16x8, wn[m][ks]), __builtin_bit_cast(bf16x8, Sb[ks]), acc, 0, 0, 0);
                    vn[m] = acc; }
                bf16_t* vdst = UT + gu2 * 4096 + (size_t)(n0 + fr) * 64 + 4 * fq; bf16_t* sdst = SOLD + gu * 4096 + (size_t)(n0 + fr) * 64 + 4 * fq;
#pragma unroll
                for (int m = 0; m < 4; ++m) { u32x2 w; w.x = cvt_pk_bf16(vn[m][0], vn[m][1]); w.y = cvt_pk_bf16(vn[m][2], vn[m][3]); *(u32x2*)(vdst + m * 16) = w;
                    u32x2 s2; s2.x = (m & 1) ? Sb[m >> 1].z : Sb[m >> 1].x; s2.y = (m & 1) ? Sb[m >> 1].w : Sb[m >> 1].y; *(u32x2*)(sdst + m * 16) = s2; }
                u32x4 Vb[2];
#pragma unroll
                for (int ks = 0; ks < 2; ++ks) { f32x4 e0, e1;
#pragma unroll
                    for (int r = 0; r < 4; ++r) { e0[r] = vn[2 * ks][r] * __expf(glast - gcv[ks][0][r]); e1[r] = vn[2 * ks + 1][r] * __expf(glast - gcv[ks][1][r]); }
                    Vb[ks] = (u32x4){cvt_pk_bf16(e0[0], e0[1]), cvt_pk_bf16(e0[2], e0[3]), cvt_pk_bf16(e1[0], e1[1]), cvt_pk_bf16(e1[2], e1[3])}; }
                const float cd = __expf(glast);
#pragma unroll
                for (int m = 0; m < 4; ++m) { f32x4 acc = Sc[m] * cd;
#pragma unroll
                    for (int ks = 0; ks < 2; ++ks) acc = __builtin_amdgcn_mfma_f32_16x16x32_bf16(__builtin_bit_cast(bf16x8, kt[m][ks]), __builtin_bit_cast(bf16x8, Vb[ks]), acc, 0, 0, 0);
                    Sc[m] = acc; }
#pragma unroll
                for (int ks = 0; ks < 2; ++ks) Sb[ks] = (u32x4){cvt_pk_bf16(Sc[2 * ks][0], Sc[2 * ks][1]), cvt_pk_bf16(Sc[2 * ks][2], Sc[2 * ks][3]), cvt_pk_bf16(Sc[2 * ks + 1][0], Sc[2 * ks + 1][1]), cvt_pk_bf16(Sc[2 * ks + 1][2], Sc[2 * ks + 1][3])};
                __syncthreads();
            }
        }
    }
}
__device__ __forceinline__ void phase_gdn_out(KA a, int l, LAS unsigned char* lds, int bid, int G, bool st = true) {
    const int tid = TIDX(), wave = tid >> 6, lane = tid & 63, fr = lane & 15, fq = lane >> 4;
    unsigned char* ws = a->ws; bf16_t* P = (bf16_t*)(ws + WS_P);
    const bf16_t* QN = (const bf16_t*)(ws + WS_QN); const bf16_t* KN = (const bf16_t*)(ws + WS_KN); const bf16_t* UT = (const bf16_t*)(ws + WS_UT); const float* GC = (const float*)(ws + WS_GC);
    LAS float* oL = (LAS float*)lds;
    const int c_lo = (l == DEPTH - 1) ? 4 : 0, ncu = 36 - c_lo;
    const int grp = wave >> 2, dir = (wave >> 1) & 1, ih = wave & 1;
    for (int up = bid; up < NB * ncu * 2; up += G) {
        const int u = 2 * up + grp;
        const int h = u & 3, c = c_lo + (u >> 2) % ncu, b = (u >> 2) / ncu, row0 = gdn_row0(b, c);
        const size_t gu = (size_t)((b * 36 + c) * 4 + h), gu2 = gu * 2 + dir;
        const bf16_t* SOLD = (const bf16_t*)(ws + (dir ? WS_SOLD1 : WS_SOLD0)) + gu * 4096;
        const float* gcp = GC + gu2 * 64;
        bf16x8 qf[2][2], kf[4][2], sfr[4][2]; u32x4 vfr[4][2]; f32x4 gj[4], gr[2]; float gi[2];
#pragma unroll
        for (int ti = 0; ti < 2; ++ti) { const int ib = 16 * (2 * ih + ti);
#pragma unroll
            for (int ks = 0; ks < 2; ++ks) qf[ti][ks] = *(const bf16x8*)(QN + gu * 4096 + (size_t)(ib + fr) * 64 + ks * 32 + fq * 8);
            gi[ti] = gcp[ib + fr]; gr[ti] = *(const f32x4*)(gcp + ib + 4 * fq); }
#pragma unroll
        for (int jt = 0; jt < 4; ++jt) {
#pragma unroll
            for (int ks = 0; ks < 2; ++ks) kf[jt][ks] = *(const bf16x8*)(KN + gu * 4096 + (size_t)(16 * jt + fr) * 64 + ks * 32 + fq * 8);
            gj[jt] = *(const f32x4*)(gcp + 16 * jt + 4 * fq); }
#pragma unroll
        for (int nt = 0; nt < 4; ++nt)
#pragma unroll
            for (int t = 0; t < 2; ++t) { const bf16_t* vp = UT + gu2 * 4096 + (size_t)(16 * nt + fr) * 64 + 32 * t + 4 * fq; const u32x2 lo = *(const u32x2*)vp, hi2 = *(const u32x2*)(vp + 16);
                vfr[nt][t] = (u32x4){lo.x, lo.y, hi2.x, hi2.y}; sfr[nt][t] = *(const bf16x8*)(SOLD + (size_t)(16 * nt + fr) * 64 + t * 32 + fq * 8); }
        const int ii = (tid >> 2) & 63, g4 = tid & 3;
        bf16_t* zp = P + (size_t)(row0 + ii) * PW + C_GZ + h * 64 + 16 * g4; const u32x4 zw0 = __builtin_nontemporal_load((const u32x4*)zp), zw1 = __builtin_nontemporal_load((const u32x4*)(zp + 8));
        u32x4 pf[2][2];
#pragma unroll
        for (int ti = 0; ti < 2; ++ti) { const int i = 16 * (2 * ih + ti) + fr;
#pragma unroll
            for (int t = 0; t < 2; ++t) { f32x4 s2[2];
#pragma unroll
                for (int hh = 0; hh < 2; ++hh) { const int jt = 2 * t + hh; f32x4 acc = (f32x4){0.f, 0.f, 0.f, 0.f};
#pragma unroll
                    for (int ks = 0; ks < 2; ++ks) acc = __builtin_amdgcn_mfma_f32_16x16x32_bf16(kf[jt][ks], qf[ti][ks], acc, 0, 0, 0);
#pragma unroll
                    for (int r = 0; r < 4; ++r) { const int j = 16 * jt + 4 * fq + r; const bool valid = dir ? (j >= i) : (j <= i); acc[r] = valid ? acc[r] * __expf(gi[ti] - gj[jt][r]) : 0.f; }
                    s2[hh] = acc; }
                pf[ti][t] = (u32x4){cvt_pk_bf16(s2[0][0], s2[0][1]), cvt_pk_bf16(s2[0][2], s2[0][3]), cvt_pk_bf16(s2[1][0], s2[1][1]), cvt_pk_bf16(s2[1][2], s2[1][3])}; } }
        __syncthreads();
#pragma unroll
        for (int ti = 0; ti < 2; ++ti) { float er[4];
#pragma unroll
            for (int r = 0; r < 4; ++r) er[r] = __expf(gr[ti][r]);
#pragma unroll
            for (int nt = 0; nt < 4; ++nt) { f32x4 o1 = (f32x4){0.f, 0.f, 0.f, 0.f}, o2 = o1;
#pragma unroll
                for (int t = 0; t < 2; ++t) o1 = __builtin_amdgcn_mfma_f32_16x16x32_bf16(__builtin_bit_cast(bf16x8, pf[ti][t]), __builtin_bit_cast(bf16x8, vfr[nt][t]), o1, 0, 0, 0);
#pragma unroll
                for (int ks = 0; ks < 2; ++ks) o2 = __builtin_amdgcn_mfma_f32_16x16x32_bf16(qf[ti][ks], sfr[nt][ks], o2, 0, 0, 0);
#pragma unroll
                for (int r = 0; r < 4; ++r) oL[((grp * 2 + dir) * 64 + 16 * (2 * ih + ti) + 4 * fq + r) * 68 + 16 * nt + fr] = o1[r] + o2[r] * er[r]; } }
        __syncthreads();
        { const LAS float* p0 = oL + ((grp * 2) * 64 + ii) * 68 + 16 * g4; const LAS float* p1 = p0 + 64 * 68;
          float o16[16]; float ss = 0.f;
#pragma unroll
          for (int q = 0; q < 4; ++q) { const f32x4 a0 = *(const LAS f32x4*)(p0 + 4 * q), b0 = *(const LAS f32x4*)(p1 + 4 * q);
#pragma unroll
              for (int j = 0; j < 4; ++j) { o16[4 * q + j] = a0[j] + b0[j]; ss += o16[4 * q + j] * o16[4 * q + j]; } }
          ss += __shfl_xor(ss, 1); ss += __shfl_xor(ss, 2);
          const float rs = rsqrtf(ss * (1.f / 64.f) + EPS);
          float z16[16]; unpack8(zw0, z16); unpack8(zw1, z16 + 8);
          const float* ng = a->gdn_norm_g + l * 64 + 16 * g4;
          float y[16];
#pragma unroll
          for (int q = 0; q < 4; ++q) { const f32x4 g0 = *(const f32x4*)(ng + 4 * q);
#pragma unroll
              for (int j = 0; j < 4; ++j) y[4 * q + j] = o16[4 * q + j] * rs * g0[j] * silu_f(z16[4 * q + j]); }
          if (st) { *(u32x4*)zp = pack8(y); *(u32x4*)(zp + 8) = pack8(y + 8); } }
    }
}

constexpr size_t WS_SGW = 2 * MiB + 256 * 1024;
__device__ __forceinline__ void phase_sg(KA a, int l, LAS unsigned char* lds, int bid, int G, bool st = true) {
    const int tid = TIDX(), wave = tid >> 6, lane = tid & 63, fr = lane & 15, fq = lane >> 4;
    bf16_t* P = (bf16_t*)(a->ws + WS_P); const bf16_t* Wb = (const bf16_t*)(a->ws + WS_SGW) + (size_t)l * 4 * 128 * 128;
    LAS unsigned char* vT = lds;
    LAS float* red = (LAS float*)(lds + 256 * TS);
    const int nch = (l == DEPTH - 1) ? 16 : 18;
    for (int it = G - 1 - bid; it < NB * nch; it += G) {
        const int b = it / nch, c = it % nch, base = c < 16 ? b * TL + c * 128 : RL + b * TC + (c - 16) * 128;
        __syncthreads();
        float v0[32], v1[32];
        { const bf16_t* r0 = P + (size_t)(base + 2 * lane) * PW + C_SV + 32 * wave;
#pragma unroll
          for (int k = 0; k < 4; ++k) { unpack8(*(const u32x4*)(r0 + 8 * k), v0 + 8 * k); unpack8(*(const u32x4*)(r0 + PW + 8 * k), v1 + 8 * k); }
          float s0 = 0.f, q0 = 0.f, s1 = 0.f, q1 = 0.f;
#pragma unroll
          for (int j = 0; j < 32; ++j) { v0[j] = gelu_f(v0[j]); v1[j] = gelu_f(v1[j]); s0 += v0[j]; q0 += v0[j] * v0[j]; s1 += v1[j]; q1 += v1[j] * v1[j]; }
          *(LAS f32x4*)(red + (wave * 64 + lane) * 4) = (f32x4){s0, q0, s1, q1}; }
        __syncthreads();
        { float s0 = 0.f, q0 = 0.f, s1 = 0.f, q1 = 0.f;
#pragma unroll
          for (int w = 0; w < 8; ++w) { const f32x4 t = *(const LAS f32x4*)(red + (w * 64 + lane) * 4); s0 += t[0]; q0 += t[1]; s1 += t[2]; q1 += t[3]; }
          const float m0 = s0 * (1.f / 256.f), m1 = s1 * (1.f / 256.f);
          const float r0 = rsqrtf(fmaxf(q0 * (1.f / 256.f) - m0 * m0, 0.f) + EPS), r1 = rsqrtf(fmaxf(q1 * (1.f / 256.f) - m1 * m1, 0.f) + EPS);
#pragma unroll
          for (int j = 0; j < 32; ++j) *(LAS unsigned*)(vT + (32 * wave + j) * TS + lane * 4) = cvt_pk_bf16((v0[j] - m0) * r0, (v1[j] - m1) * r1); }
        __syncthreads();
        const int h = wave >> 1, ih = wave & 1; const bf16_t* Wh = Wb + (size_t)h * 128 * 128; const float* bs = a->sg_b + ((size_t)l * 4 + h) * 128;
#pragma unroll 2
        for (int itl = 0; itl < 4; ++itl) { const int i = 64 * ih + 16 * itl + fr;
            bf16x8 bfr[4];
#pragma unroll
            for (int ks = 0; ks < 4; ++ks) bfr[ks] = *(const bf16x8*)(Wh + (size_t)i * 128 + ks * 32 + fq * 8);
            const float bias = bs[i]; bf16_t* rowp = P + (size_t)(base + i) * PW + h * 64 + 4 * fq;
#pragma unroll
            for (int dt = 0; dt < 4; ++dt) { f32x4 acc = (f32x4){0.f, 0.f, 0.f, 0.f};
#pragma unroll
                for (int ks = 0; ks < 4; ++ks) { const bf16x8 afr = *(const LAS bf16x8*)(vT + (h * 64 + 16 * dt + fr) * TS + (ks * 32 + fq * 8) * 2); acc = __builtin_amdgcn_mfma_f32_16x16x32_bf16(afr, bfr[ks], acc, 0, 0, 0); }
                const u32x2 uw = *(const u32x2*)(rowp + C_SU + 16 * dt), zw = *(const u32x2*)(rowp + C_SZ + 16 * dt);
                const float u4[4] = {bf2f(uw.x & 0xffffu), bf2f(uw.x >> 16), bf2f(uw.y & 0xffffu), bf2f(uw.y >> 16)}, z4[4] = {bf2f(zw.x & 0xffffu), bf2f(zw.x >> 16), bf2f(zw.y & 0xffffu), bf2f(zw.y >> 16)};
                float y[4];
#pragma unroll
                for (int r = 0; r < 4; ++r) y[r] = gelu_f(u4[r]) * (acc[r] + bias) * silu_f(z4[r]);
                u32x2 o; o.x = cvt_pk_bf16(y[0], y[1]); o.y = cvt_pk_bf16(y[2], y[3]); if (st) *(u32x2*)(rowp + C_SU + 16 * dt) = o; } }
    }
}

__device__ __forceinline__ void phase_chain_and_ret(KA a, int l, LAS unsigned char* lds, int bid, int G) {
    const int N = NB * ((l == DEPTH - 1) ? 16 : 18) * 4;
    if (G >= 256) { const int n_tail = 3 * 128;
        if (bid < 128) { phase_gdn_chain(a, l, lds, bid, 128); phase_ret_out(a, l, lds, bid, 128, N - n_tail, N); }
        else phase_ret_out(a, l, lds, bid - 128, G - 128, 0, N - n_tail); }
    else { phase_gdn_chain(a, l, lds, bid, G); phase_ret_out(a, l, lds, bid, G, 0, N); }
}

#define XB_TMO      128
#define XB_XCNT(j)  (256  + 64 * (j))
#define XB_XSUB(j)  (1280 + 64 * (j))
#define XB_XGEN(j)  (2304 + 64 * (j))
#define XB_TOP      3328
#define XB_TOPGEN   3392
#define XCD_BAR_WORDS 3456
#define XB_SPIN_CAP (1u << 18)
__device__ __forceinline__ unsigned xb_ld(unsigned* p)              { return __hip_atomic_load(p, __ATOMIC_RELAXED, __HIP_MEMORY_SCOPE_AGENT); }
__device__ __forceinline__ unsigned xb_add(unsigned* p, unsigned v) { return __hip_atomic_fetch_add(p, v, __ATOMIC_RELAXED, __HIP_MEMORY_SCOPE_AGENT); }
__device__ __forceinline__ unsigned xb_xcc_id() { return (unsigned)__builtin_amdgcn_s_getreg((3 << 11) | 20) & 0xFu; }
#define XB_SPIN(cond, bar) do { unsigned _sp = 0; while (cond) { __builtin_amdgcn_s_sleep(1); \
    if ((++_sp & 255u) == 0u) { if (xb_ld(&(bar)[XB_TMO])) break; if (_sp > XB_SPIN_CAP) { atomicAdd(&(bar)[XB_TMO], 1u); break; } } } } while (0)
struct XcdBarrier { unsigned* bar; unsigned x; volatile LAS unsigned* st; };
__device__ __forceinline__ XcdBarrier xcd_barrier_post(unsigned* bar, volatile LAS unsigned* st) {
    XcdBarrier b; b.bar = bar; b.x = xb_xcc_id(); b.st = st;
    if (threadIdx.x == 0) (void)xb_add(&bar[XB_XCNT(b.x)], 1u);
    return b;
}
__device__ __forceinline__ void xcd_barrier_complete(unsigned* bar, unsigned x, unsigned& nloc, unsigned& nx) {
    const unsigned G = gridDim.x * gridDim.y * gridDim.z;
    unsigned sum, cnt, mine, sp = 0u;
    for (;;) {
        sum = 0u; cnt = 0u; mine = 0u;
#pragma unroll
        for (unsigned j = 0; j < 16; ++j) { const unsigned c = xb_ld(&bar[XB_XCNT(j)]); sum += c; cnt += (c > 0u) ? 1u : 0u; mine = (j == x) ? c : mine; }
        if (sum == G) break;
        __builtin_amdgcn_s_sleep(1);
        if ((++sp & 255u) == 0u) { if (xb_ld(&bar[XB_TMO])) break; if (sp > XB_SPIN_CAP) { atomicAdd(&bar[XB_TMO], 1u); break; } }
    }
    nloc = mine > 0u ? mine : 1u; nx = cnt > 0u ? cnt : 1u;
}
__device__ __forceinline__ void xcd_barrier(const XcdBarrier& b) {
    asm volatile("s_waitcnt vmcnt(0)" ::: "memory");
    __syncthreads();
    if (threadIdx.x == 0) {
        unsigned* bar = b.bar;
        __builtin_amdgcn_s_waitcnt(0);
        unsigned nloc = b.st[0], nx = b.st[1];
        if (nloc == 0u) { xcd_barrier_complete(bar, b.x, nloc, nx); b.st[0] = nloc; b.st[1] = nx; }
        const unsigned old = xb_add(&bar[XB_XSUB(b.x)], 1u);
        const unsigned gen = old / nloc;
        if (old + 1u == (gen + 1u) * nloc) {
            __builtin_amdgcn_fence(__ATOMIC_RELEASE, "agent");
            asm volatile("s_waitcnt vmcnt(0)" ::: "memory");
            const unsigned og = xb_add(&bar[XB_TOP], 1u);
            const unsigned tg = og / nx;
            if (og + 1u == (tg + 1u) * nx) xb_add(&bar[XB_TOPGEN], 1u);
            else XB_SPIN(xb_ld(&bar[XB_TOPGEN]) == tg, bar);
            __builtin_amdgcn_fence(__ATOMIC_ACQUIRE, "agent");
            xb_add(&bar[XB_XGEN(b.x)], 1u);
            asm volatile("s_waitcnt vmcnt(0)" ::: "memory");
        } else {
            XB_SPIN(xb_ld(&bar[XB_XGEN(b.x)]) == gen, bar);
            __builtin_amdgcn_fence(__ATOMIC_ACQUIRE, "agent");
            asm volatile("s_waitcnt vmcnt(0)" ::: "memory");
        }
    }
    __syncthreads();
}

constexpr int STEPS_PER_LAYER = 6, N_STEPS = 1 + DEPTH * STEPS_PER_LAYER + 1;

__global__ void __launch_bounds__(512, 2) fwd_megakernel(Args a) {
    extern __shared__ __attribute__((aligned(16))) unsigned char lds_raw[];
    LAS unsigned char* lds = (LAS unsigned char*)lds_raw;
    cg::grid_group grid = cg::this_grid();
    const int bid = blockIdx.x, G = gridDim.x;
    const int st_lo = a.st_lo, st_hi = a.st_hi, coop = a.coop;
    KA ka = (KA)__builtin_amdgcn_kernarg_segment_ptr();
#if PROBE_K >= 0
    unsigned long long* ts = (unsigned long long*)(a.ws + WS_CTL + 15360);
#define STAMP(i) do { if (bid == 0 && threadIdx.x == 0) ts[i] = __builtin_amdgcn_s_memrealtime(); } while (0)
#else
#define STAMP(i) do { } while (0)
#endif
    volatile LAS unsigned* xst = (volatile LAS unsigned*)(lds + LDS_BYTES - 64);
    if (threadIdx.x < 2) xst[threadIdx.x] = 0u;
    __syncthreads();
    const XcdBarrier xb = xcd_barrier_post((unsigned*)(a.ws + WS_CTL), xst);
#define STEP(idx, call) do { const int _i = (idx); if (st_lo <= _i && _i < st_hi) { STAMP(_i); call; if (_i + 1 < st_hi) { if (coop) { if (_i == 0) grid.sync(); else xcd_barrier(xb); } else __syncthreads(); } } } while (0)
    STEP(0, phase_prologue(ka, lds, bid, G));
#define NOST (ka->pad == 777)
#if PROBE_R == 26
#define PROBE_A(l, s0) STEP(s0 + 0, phase_norm(ka, l, bid, G, NOST));
#else
#define PROBE_A(l, s0)
#endif
#if PROBE_R == 21
#define PROBE_C(l) phase_ret_kv(ka, l, lds, bid, G),
#elif PROBE_R == 22
#define PROBE_C(l) phase_sg(ka, l, lds, bid, G, NOST),
#elif PROBE_R == 23
#define PROBE_C(l) phase_sc(ka, l, bid, G, NOST),
#else
#define PROBE_C(l)
#endif
#if PROBE_R == 24
#define PROBE_E(l, s0) STEP(s0 + 4, phase_gdn_out(ka, l, lds, bid, G, NOST));
#elif PROBE_R == 25
#define PROBE_E(l, s0) STEP(s0 + 4, phase_ret_out(ka, l, lds, bid, G, 0, NB * ((l == DEPTH - 1) ? 16 : 18) * 4, NOST));
#else
#define PROBE_E(l, s0)
#endif
#define LAYER(l) do { constexpr int s0 = 1 + (l) * STEPS_PER_LAYER; \
        PROBE_A(l, s0) STEP(s0 + 0, phase_norm(ka, l, bid, G)); \
        STEP(s0 + 1, phase_gemm(ka, l, false, lds, bid, G)); \
        STEP(s0 + 2, (phase_gdn_prep2(ka, l, lds, bid, G), phase_ret_kv(ka, l, lds, bid, G), PROBE_C(l) phase_sg(ka, l, lds, bid, G), phase_sc(ka, l, bid, G))); \
        STEP(s0 + 3, phase_chain_and_ret(ka, l, lds, bid, G)); \
        PROBE_E(l, s0) \
        STEP(s0 + 4, phase_gdn_out(ka, l, lds, bid, G)); \
        STEP(s0 + 5, phase_gemm(ka, l, true, lds, bid, G)); } while (0)
    LAYER(0); LAYER(1); LAYER(2); LAYER(3);
    STEP(N_STEPS - 1, phase_norm(ka, DEPTH, bid, G));
#if PROBE_K >= 0
    STAMP(N_STEPS);
    __syncthreads();
    if (bid == 0 && threadIdx.x == 0) { unsigned long long tot = 0;
        for (int i = 0; i < N_STEPS; ++i) { const int cls = i == 0 ? 0 : (i == N_STEPS - 1 ? 1 : 1 + (i - 1) % STEPS_PER_LAYER); if (cls == PROBE_K || PROBE_K == 99) tot += ts[i + 1] - ts[i]; }
        a.out[0] = (float)tot * 0.01f; }
#endif
#undef STEP
}

extern "C" void kernel_launch(void* const* d_in, const int* in_sizes, int n_in, void* d_out, int out_size, void* d_ws, size_t ws_size, hipStream_t stream) {
    static int grid = 0;
    if (grid == 0) {
        int dev = 0, cus = 0, per_cu = 0;
        hipGetDevice(&dev); hipDeviceGetAttribute(&cus, hipDeviceAttributeMultiprocessorCount, dev);
        if (hipFuncSetAttribute((const void*)fwd_megakernel, hipFuncAttributeMaxDynamicSharedMemorySize, LDS_BYTES) != hipSuccess) { fprintf(stderr, "hipFuncSetAttribute failed\n"); grid = -1; return; }
        if (hipOccupancyMaxActiveBlocksPerMultiprocessor(&per_cu, (const void*)fwd_megakernel, 512, LDS_BYTES) != hipSuccess || per_cu < 1) { fprintf(stderr, "occupancy query failed (%d)\n", per_cu); per_cu = 1; }
        (void)hipGetLastError();
        grid = cus * per_cu;
        if (ws_size < WS_END2) { fprintf(stderr, "workspace too small: %zu < %zu\n", ws_size, (size_t)WS_END); grid = -1; return; }
    }
    if (grid < 0) return;
    Args a{};
    const float** ap = (const float**)&a;
    for (int i = 0; i < 18; ++i) ap[i] = (const float*)d_in[i];
    a.out = (float*)d_out; a.ws = (unsigned char*)d_ws;
    hipMemsetAsync((char*)d_ws + WS_CTL, 0, 16384, stream);
#if MK_MULTI
    for (int st = 0; st < N_STEPS; ++st) { a.st_lo = st; a.st_hi = st + 1; a.coop = 0; hipLaunchKernelGGL(fwd_megakernel, dim3(grid), dim3(512), LDS_BYTES, stream, a); }
#else
    a.st_lo = 0; a.st_hi = N_STEPS; a.coop = 1;
    void* args[] = {&a};
    hipError_t e = hipLaunchCooperativeKernel((const void*)fwd_megakernel, dim3(grid), dim3(512), args, LDS_BYTES, stream);
    if (e != hipSuccess) fprintf(stderr, "cooperative launch failed: %s (grid %d)\n", hipGetErrorString(e), grid);
#endif
}
```

```cpp
#include <hip/hip_runtime.h>
#include <hip/hip_cooperative_groups.h>
#include <cstdint>
#include <cstdio>
namespace cg = cooperative_groups;

#ifndef EXP_NOINPLACE
#define EXP_NOINPLACE 0
#endif
#ifndef EXP_NJ
#define EXP_NJ 18
#endif
#ifndef OPT_GDN
#define OPT_GDN 1
#endif
#ifndef OPT_SG
#define OPT_SG 1
#endif
#ifndef PROBE_K
#define PROBE_K -1
#endif
#ifndef PROBE_R
#define PROBE_R 0
#endif
#ifndef OPT_RET
#define OPT_RET 1
#endif
#ifndef MK_MULTI
#define MK_MULTI 0
#endif

#define LAS __attribute__((address_space(3)))
__device__ __forceinline__ int TIDX() { int t = threadIdx.x; asm volatile("" : "+v"(t)); return t; }
typedef unsigned short bf16_t;
typedef short bf16x8 __attribute__((ext_vector_type(8)));
typedef float f32x4 __attribute__((ext_vector_type(4)));
typedef float f32x2 __attribute__((ext_vector_type(2)));
typedef unsigned u32x4 __attribute__((ext_vector_type(4)));
typedef unsigned u32x2 __attribute__((ext_vector_type(2)));

constexpr int DM = 1024, NB = 16, TL = 2048, TC = 256, DEPTH = 4;
constexpr int RL = NB * TL, RC = NB * TC, RT = RL + RC;
constexpr int PW = 3840, INW = 3856;
constexpr float EPS = 1e-6f;
constexpr unsigned long long POSPACK = 0xCEDBA9786543210ull;
constexpr int C_RQ = 0, C_RK = 256, C_RV = 512, C_RZ = 768, C_SU = 1024, C_SV = 1280, C_SZ = 1536, C_CC = 1792, C_CB = 2048, C_CH = 2304, C_CZ = 2560,
              C_GQ = 2816, C_GZ = 3072, C_GK = 3328, C_GV = 3584;

constexpr size_t MiB = 1u << 20;
constexpr size_t WS_CTL = 0;
constexpr size_t WS_ROPE = 512 * 1024;
constexpr size_t WS_MOD = 1 * MiB;
constexpr size_t WS_WEXT = 2 * MiB;
constexpr size_t WS_WIN = 3 * MiB;
constexpr size_t WS_WOUT = 33 * MiB;
constexpr size_t WS_XC = 41 * MiB;
constexpr size_t WS_EXT = 57 * MiB;
constexpr size_t WS_KV = 60 * MiB;
constexpr size_t WS_X = 78 * MiB;
constexpr size_t WS_O = WS_X, WS_H = WS_X + 72 * MiB;
constexpr size_t WS_P = 222 * MiB;
constexpr size_t WS_GB = 492 * MiB;
constexpr size_t WS_END = 495 * MiB;
constexpr size_t WS_OG = WS_X;
constexpr size_t WS_GQ = WS_X + 72 * MiB, WS_GK = WS_GQ + 18 * MiB, WS_GV = WS_GK + 18 * MiB;
constexpr size_t WS_SGV = WS_X + 72 * MiB;

constexpr int LDS_BYTES = 147456;

struct Args {
    const float *x, *c, *ctx, *c_ctx, *w_mod, *b_mod, *g_pre, *g_post, *w_in, *w_out, *ret_norm_g, *sg_w, *sg_b, *sc_conv_w, *gdn_conv_w, *gdn_a_log, *gdn_dt_bias, *gdn_norm_g;
    float* out; unsigned char* ws; int st_lo, st_hi, coop, pad;
};

typedef const __attribute__((address_space(4))) Args* KA;

__device__ __forceinline__ float bf2f(unsigned v) { return __uint_as_float(v << 16); }
typedef __bf16 bf16v2_t __attribute__((ext_vector_type(2)));
__device__ __forceinline__ unsigned cvt_pk_bf16(float lo, float hi) { const f32x2 f = {lo, hi}; return __builtin_bit_cast(unsigned, __builtin_convertvector(f, bf16v2_t)); }
__device__ __forceinline__ unsigned f2bf(float f) { return cvt_pk_bf16(f, 0.f) & 0xffffu; }
__device__ __forceinline__ float wave_sum(float v) {
#pragma unroll
    for (int o = 1; o < 64; o <<= 1) v += __shfl_xor(v, o);
    return v;
}
__device__ __forceinline__ float silu_f(float x) { return x / (1.f + __expf(-x)); }
__device__ __forceinline__ float gelu_f(float x) { const float u = 0.7978845608028654f * (x + 0.044715f * x * x * x); return x / (1.f + __expf(-2.f * u)); }
__device__ __forceinline__ float softplus_f(float x) { return x > 20.f ? x : log1pf(__expf(x)); }
__device__ __forceinline__ float sigmoid_f(float x) { return 1.f / (1.f + __expf(-x)); }

namespace pg8 {
constexpr int BM = 256, BK = 64, HALF = 128, HTB = HALF * BK * 2, STAGE_BYTES = 8 * HTB, NXCD = 8, WGM = 8;
__host__ __device__ __forceinline__ int lds_byte(int r, int c) { const int st = (r >> 4) * 2 + (c >> 5), rr = r & 15, cc = c & 31, ob = rr * 64 + cc * 2; return st * 1024 + (ob ^ (((ob >> 9) & 1) << 5)); }
__host__ __device__ __forceinline__ void stage_rc(int b, int& R, int& C) { const int st = b / 1024, sb = b % 1024, swz = sb ^ (((sb >> 9) & 1) << 5); R = (st >> 1) * 16 + swz / 64; C = (st & 1) * 32 + (swz % 64) / 2; }
__host__ __device__ __forceinline__ int perm32(int rho) { const int n = rho >> 4, i = rho & 15; return 8 * (i >> 2) + 4 * n + (i & 3); }
struct Unit { int pm, pn; };
struct Gemm { const bf16_t* A; const bf16_t* Bt; int M, N, K, lda, seg; };
struct StaticOrder {
    int nM, nN, nwg, G, c;
    __host__ __device__ void init(int M, int N, int G_, int c_) { nM = M / BM; nN = N / BM; nwg = nM * nN; G = G_; c = c_; }
    __host__ __device__ bool next(int i, Unit& u) const {
        const long L = (long)i * G + c; if (L >= nwg) return false;
        int wgid = (int)L; { const int q = nwg / NXCD, r = nwg % NXCD, xcd = wgid % NXCD, off = wgid / NXCD; wgid = (xcd < r ? xcd * (q + 1) : r * (q + 1) + (xcd - r) * q) + off; }
        const int nig = WGM * nN, gid = wgid / nig, fm = gid * WGM, gsz = (nM - fm) < WGM ? (nM - fm) : WGM;
        u.pm = fm + ((wgid % nig) % gsz); u.pn = (wgid % nig) / gsz; return true;
    }
};
struct EpiBf16 {
    bf16_t* O; int ldc;
    __device__ __forceinline__ void operator()(const f32x4 (&acc)[2][2][4][2], const Unit& u, int wr, int wc, int fr, int fq) const {
        const int row0 = u.pm * BM + wr * 64 + fr, col0 = u.pn * BM + wc * 32 + 8 * fq;
#pragma unroll
        for (int ai = 0; ai < 2; ++ai)
#pragma unroll
            for (int m = 0; m < 4; ++m) { bf16_t* rowp = O + (size_t)(row0 + ai * HALF + m * 16) * ldc + col0;
#pragma unroll
                for (int bj = 0; bj < 2; ++bj) { const f32x4 v0 = acc[ai][bj][m][0], v1 = acc[ai][bj][m][1];
                    u32x4 w; w.x = cvt_pk_bf16(v0[0], v0[1]); w.y = cvt_pk_bf16(v0[2], v0[3]); w.z = cvt_pk_bf16(v1[0], v1[1]); w.w = cvt_pk_bf16(v1[2], v1[3]);
                    *(u32x4*)(rowp + bj * HALF) = w; } }
    }
};

template <class Epi>
__device__ __forceinline__ void gemm_phase(LAS unsigned char* lds, const Gemm g, const StaticOrder& S, const Epi& E) {
    const int tid = TIDX(), wid = __builtin_amdgcn_readfirstlane(tid >> 6), lane = tid & 63, wr = wid >> 2, wc = wid & 3, fr = lane & 15, fq = lane >> 4;
    const int K = g.K, nt = K / BK, lda = g.lda, seg = g.seg;
    unsigned voffA[2], voffB[2];
#pragma unroll
    for (int i = 0; i < 2; ++i) { int R, C; stage_rc(tid * 16 + i * 8192, R, C); const int Rb = (R & ~31) + perm32(R & 31);
        voffA[i] = (unsigned)(R * lda + C) * 2u; voffB[i] = (unsigned)(Rb * K + C) * 2u; }
    const size_t kstep = (size_t)(BK * 2);
    const size_t hstepA = (size_t)HALF * lda * 2, hstepB = (size_t)HALF * K * 2;
    const size_t tstepA = 2 * hstepA, tstepB = 2 * hstepB;
#define KOFFA(t) (seg ? ((size_t)((t) >> 2) * 2048 + (size_t)((t) & 3) * 128) : (size_t)(t) * 128)
    const unsigned ldsw = (unsigned)wid * 1024u;
    const int aoff = lds_byte(wr * 64 + fr, fq * 8), boff = lds_byte(wc * 32 + fr, fq * 8);
#define PG8_SA(b, h) (((b) * 2 + (h)) * HTB)
#define PG8_SB(b, h) ((4 + (b) * 2 + (h)) * HTB)
#define PG8_STAGE(bufoff, gbase, voff) do { _Pragma("unroll") for (int _i = 0; _i < 2; ++_i) \
        __builtin_amdgcn_global_load_lds((const unsigned*)((const char*)(gbase) + (voff)[_i]), (LAS unsigned*)(lds + (bufoff) + ldsw + _i * 8192), 16, 0, 0); } while (0)
#define PG8_LDA(dst, b, h) do { _Pragma("unroll") for (int m = 0; m < 4; ++m) _Pragma("unroll") for (int k = 0; k < 2; ++k) dst[m][k] = *(const LAS bf16x8*)(lds + PG8_SA(b, h) + aoff + m * 2048 + k * 1024); } while (0)
#define PG8_LDB(dst, b, h) do { _Pragma("unroll") for (int n = 0; n < 2; ++n) _Pragma("unroll") for (int k = 0; k < 2; ++k) dst[n][k] = *(const LAS bf16x8*)(lds + PG8_SB(b, h) + boff + n * 2048 + k * 1024); } while (0)
#define PG8_MMA(ai, bj, At, Bt) do { __builtin_amdgcn_s_setprio(1); _Pragma("unroll") for (int m = 0; m < 4; ++m) _Pragma("unroll") for (int n = 0; n < 2; ++n) _Pragma("unroll") for (int k = 0; k < 2; ++k) \
        acc[ai][bj][m][n] = __builtin_amdgcn_mfma_f32_16x16x32_bf16(Bt[n][k], At[m][k], acc[ai][bj][m][n], 0, 0, 0); __builtin_amdgcn_s_setprio(0); } while (0)
#define PG8_WAIT_V(n) asm volatile("s_waitcnt vmcnt(" #n ")" ::: "memory")
#define PG8_WAIT_L(n) asm volatile("s_waitcnt lgkmcnt(" #n ")" ::: "memory")
#define PG8_BAR __builtin_amdgcn_s_barrier()
#define PG8_SCHED __builtin_amdgcn_sched_barrier(0)
    Unit cur, nxt; int ui = 0;
    if (!S.next(0, cur)) return;
    f32x4 acc[2][2][4][2];
#pragma unroll
    for (int a = 0; a < 2; ++a)
#pragma unroll
        for (int b = 0; b < 2; ++b)
#pragma unroll
            for (int m = 0; m < 4; ++m)
#pragma unroll
                for (int n = 0; n < 2; ++n) acc[a][b][m][n] = (f32x4){0.f, 0.f, 0.f, 0.f};
    bf16x8 At[4][2], B0[2][2], B1[2][2];
    const char* cA = (const char*)g.A + (size_t)cur.pm * tstepA; const char* cB = (const char*)g.Bt + (size_t)cur.pn * tstepB;
    PG8_STAGE(PG8_SB(0, 0), cB, voffB); PG8_STAGE(PG8_SB(0, 1), cB + hstepB, voffB); PG8_STAGE(PG8_SA(0, 0), cA, voffA); PG8_STAGE(PG8_SA(0, 1), cA + hstepA, voffA);
    if (wr == 1) PG8_BAR;
    PG8_WAIT_V(2); PG8_BAR;
    PG8_STAGE(PG8_SB(1, 0), cB + kstep, voffB); PG8_STAGE(PG8_SA(1, 0), cA + KOFFA(1), voffA); PG8_STAGE(PG8_SB(1, 1), cB + hstepB + kstep, voffB);
    PG8_WAIT_V(6); PG8_BAR;
    for (;;) {
        const bool has_next = S.next(ui + 1, nxt);
        const char* nA = has_next ? (const char*)g.A + (size_t)nxt.pm * tstepA : cA; const char* nB = has_next ? (const char*)g.Bt + (size_t)nxt.pn * tstepB : cB;
        for (int t = 0; t < nt; t += 2) {
            const bool last = (t == nt - 2);
            const char* a1 = cA + KOFFA(t + 1);
            const char* a2 = last ? nA : cA + KOFFA(t + 2); const char* b2 = last ? nB : cB + (size_t)(t + 2) * kstep;
            const char* a3 = last ? nA + KOFFA(1) : cA + KOFFA(t + 3); const char* b3 = b2 + kstep;
            PG8_LDB(B0, 0, 0); PG8_LDB(B1, 0, 1); PG8_SCHED; PG8_LDA(At, 0, 0); PG8_STAGE(PG8_SA(1, 1), a1 + hstepA, voffA);
            PG8_WAIT_V(8); PG8_WAIT_L(0); PG8_BAR; PG8_MMA(0, 0, At, B0); PG8_MMA(0, 1, At, B1); PG8_BAR; PG8_SCHED;
            PG8_LDA(At, 0, 1); PG8_STAGE(PG8_SB(0, 0), b2, voffB); PG8_STAGE(PG8_SB(0, 1), b2 + hstepB, voffB); PG8_STAGE(PG8_SA(0, 0), a2, voffA);
            PG8_WAIT_V(8); PG8_WAIT_L(0); PG8_BAR; PG8_MMA(1, 0, At, B0); PG8_MMA(1, 1, At, B1); PG8_BAR; PG8_SCHED;
            PG8_LDB(B0, 1, 0); PG8_LDB(B1, 1, 1); PG8_SCHED; PG8_LDA(At, 1, 0); PG8_STAGE(PG8_SA(0, 1), a2 + hstepA, voffA);
            PG8_WAIT_V(8); PG8_WAIT_L(0); PG8_BAR; PG8_MMA(0, 0, At, B0); PG8_MMA(0, 1, At, B1); PG8_BAR; PG8_SCHED;
            PG8_LDA(At, 1, 1); PG8_STAGE(PG8_SB(1, 0), b3, voffB); PG8_STAGE(PG8_SB(1, 1), b3 + hstepB, voffB); PG8_STAGE(PG8_SA(1, 0), a3, voffA);
            PG8_WAIT_V(8); PG8_WAIT_L(0); PG8_BAR; PG8_MMA(1, 0, At, B0); PG8_MMA(1, 1, At, B1); PG8_BAR; PG8_SCHED;
        }
        if (wr == 0) PG8_BAR;
        E(acc, cur, wr, wc, fr, fq);
        if (!has_next) break;
#pragma unroll
        for (int a = 0; a < 2; ++a)
#pragma unroll
            for (int b = 0; b < 2; ++b)
#pragma unroll
                for (int m = 0; m < 4; ++m)
#pragma unroll
                    for (int n = 0; n < 2; ++n) acc[a][b][m][n] = (f32x4){0.f, 0.f, 0.f, 0.f};
        cur = nxt; cA = nA; cB = nB; ++ui;
        if (wr == 1) PG8_BAR;
    }
    PG8_WAIT_V(0);
    PG8_BAR;
#undef KOFFA
#undef PG8_SA
#undef PG8_SB
#undef PG8_STAGE
#undef PG8_LDA
#undef PG8_LDB
#undef PG8_MMA
#undef PG8_WAIT_V
#undef PG8_WAIT_L
#undef PG8_BAR
#undef PG8_SCHED
}
}

__device__ __forceinline__ int seq_row(int b, int s) { return s < TC ? RL + b * TC + s : b * TL + (s - TC); }

__device__ __forceinline__ void transpose_item(const float* W, int N, int item, int nblk, bf16_t* dst_main, bf16_t* dst_ext, bool is_in, LAS float* scr, int lane) {
    const int kb = item / nblk, nb = item % nblk, k0 = 64 * kb, n0 = 32 * nb;
    { const int n = n0 + (lane & 31);
#pragma unroll 8
      for (int i = 0; i < 32; ++i) { const int kk = 2 * i + (lane >> 5); scr[kk * 33 + (lane & 31)] = n < N ? __builtin_nontemporal_load(W + (size_t)(k0 + kk) * N + n) : 0.f; } }
    asm volatile("s_waitcnt lgkmcnt(0)" ::: "memory");
    const int c = lane & 7;
#pragma unroll
    for (int j = 0; j < 4; ++j) { const int nl = (lane >> 3) + 8 * j, n = n0 + nl; const LAS float* s = scr + (8 * c) * 33 + nl;
        u32x4 o; o.x = cvt_pk_bf16(s[0 * 33], s[1 * 33]); o.y = cvt_pk_bf16(s[2 * 33], s[3 * 33]); o.z = cvt_pk_bf16(s[4 * 33], s[5 * 33]); o.w = cvt_pk_bf16(s[6 * 33], s[7 * 33]);
        if (n < N) { bf16_t* rowp;
            if (is_in) { if (n < PW) { const int sg = n >> 8, pos = (int)((POSPACK >> (4 * sg)) & 15ull); rowp = dst_main + (size_t)(pos * 256 + (n & 255)) * DM; } else rowp = dst_ext + (size_t)(n - PW) * DM; }
            else rowp = dst_main + (size_t)n * DM;
            *(u32x4*)(rowp + k0 + 8 * c) = o; } }
    asm volatile("s_waitcnt lgkmcnt(0)" ::: "memory");
}

__device__ __forceinline__ void phase_prologue(KA a, LAS unsigned char* lds, int bid, int G) {
    const int tid = TIDX(), wave = tid >> 6, lane = tid & 63;
    unsigned char* ws = a->ws;
    if (bid == G - 1) { float* rope = (float*)(ws + WS_ROPE);
        for (int i = tid; i < 1024; i += 512) { const int pos = i >> 4, f = i & 15; const float inv = expf(-9.210340371976184f * (float)f * (1.f / 16.f)); const float ang = (float)pos * inv;
            rope[i] = cosf(ang); rope[1024 + i] = sinf(ang); } }
    for (int it = bid; it < 96; it += G) {
        LAS float* s = (LAS float*)lds;
        for (int i = tid; i < 17 * 1024; i += 512) { const int r = i >> 10, k = i & 1023; const float v = r < 16 ? a->c[r * 1024 + k] : a->c_ctx[k]; s[i] = silu_f(v); }
        __syncthreads();
        const int l = it / 24, j0 = (it % 24) * 128;
        f32x2 acc[17];
#pragma unroll
        for (int r = 0; r < 17; ++r) acc[r] = (f32x2){0.f, 0.f};
        const float* wp = a->w_mod + ((size_t)l * 1024 + wave * 128) * 3072 + j0 + lane * 2;
#pragma unroll 4
        for (int k = 0; k < 128; ++k) { const f32x2 w2 = __builtin_nontemporal_load((const f32x2*)(wp + (size_t)k * 3072));
#pragma unroll
            for (int r = 0; r < 17; ++r) { const float sv = s[r * 1024 + wave * 128 + k]; acc[r] += sv * w2; } }
        __syncthreads();
        LAS float* part = (LAS float*)lds;
#pragma unroll
        for (int r = 0; r < 17; ++r) *(LAS f32x2*)(part + (wave * 17 + r) * 128 + lane * 2) = acc[r];
        __syncthreads();
        float* mod = (float*)(ws + WS_MOD);
        for (int i = tid; i < 17 * 128; i += 512) { const int r = i >> 7, cc = i & 127; float v = a->b_mod[l * 3072 + j0 + cc];
#pragma unroll
            for (int w = 0; w < 8; ++w) v += part[(w * 17 + r) * 128 + cc];
            mod[((size_t)l * 17 + r) * 3072 + j0 + cc] = v; }
        __syncthreads();
    }
    __syncthreads();
    { bf16_t* sgw = (bf16_t*)(ws + 2 * MiB + 256 * 1024);
      for (int i = bid * 512 + tid; i < DEPTH * 4 * 128 * 128 / 8; i += G * 512) { const f32x4 x0 = *(const f32x4*)(a->sg_w + (size_t)i * 8), x1 = *(const f32x4*)(a->sg_w + (size_t)i * 8 + 4);
          u32x4 w; w.x = cvt_pk_bf16(x0[0], x0[1]); w.y = cvt_pk_bf16(x0[2], x0[3]); w.z = cvt_pk_bf16(x1[0], x1[1]); w.w = cvt_pk_bf16(x1[2], x1[3]); *(u32x4*)(sgw + (size_t)i * 8) = w; } }
    LAS float* scr = (LAS float*)lds + wave * (64 * 33);
    const int gw = bid * 8 + wave, NGW = G * 8;
    constexpr int I_IN = 16 * 121, I_OUT = 16 * 32, NIT = DEPTH * (I_IN + I_OUT);
    for (int it = gw; it < NIT; it += NGW) {
        const int l = it / (I_IN + I_OUT), r = it % (I_IN + I_OUT);
        if (r < I_IN) transpose_item(a->w_in + (size_t)l * DM * INW, INW, r, 121, (bf16_t*)(ws + WS_WIN) + (size_t)l * PW * DM, (bf16_t*)(ws + WS_WEXT) + (size_t)l * 16 * DM, true, scr, lane);
        else transpose_item(a->w_out + (size_t)l * DM * DM, DM, r - I_IN, 32, (bf16_t*)(ws + WS_WOUT) + (size_t)l * DM * DM, nullptr, false, scr, lane);
    }
}

__device__ __forceinline__ void phase_norm(KA a, int l, int bid, int G, bool st = true) {
    const int tid = TIDX(), wave = tid >> 6, lane = tid & 63;
    unsigned char* ws = a->ws;
    const float* mod = (const float*)(ws + WS_MOD);
    const bf16_t* O = (const bf16_t*)(ws + WS_O); bf16_t* H = (bf16_t*)(ws + WS_H); float* XC = (float*)(ws + WS_XC);
    const int nrows = (l == DEPTH) ? RL : RT, stride = G * 8;
    auto xptr = [&](int r) { const bool is_ctx = r >= RL; return (l <= 1) ? (is_ctx ? a->ctx + (size_t)(r - RL) * DM : a->x + (size_t)r * DM) : (is_ctx ? XC + (size_t)(r - RL) * DM : a->out + (size_t)r * DM); };
    f32x4 gp4[4], gpre4[4];
#pragma unroll
    for (int j = 0; j < 4; ++j) { const int col = 4 * lane + 256 * j;
        gp4[j] = (l > 0) ? *(const f32x4*)(a->g_post + (size_t)(l - 1) * DM + col) : (f32x4){0.f, 0.f, 0.f, 0.f};
        gpre4[j] = (l < DEPTH) ? *(const f32x4*)(a->g_pre + (size_t)l * DM + col) : (f32x4){0.f, 0.f, 0.f, 0.f}; }
    int r = bid * 8 + wave;
    f32x4 vn[4], gtn[4], shn[4], scn[4]; u32x2 on[4];
    auto prefetch = [&](int rr) { const float* xp = xptr(rr); const int mr = rr >= RL ? 16 : (rr >> 11);
        const float* gate = mod + ((size_t)(l > 0 ? l - 1 : 0) * 17 + mr) * 3072 + 2048; const float* mrow = mod + ((size_t)(l < DEPTH ? l : 0) * 17 + mr) * 3072;
#pragma unroll
        for (int j = 0; j < 4; ++j) { const int col = 4 * lane + 256 * j; vn[j] = __builtin_nontemporal_load((const f32x4*)(xp + col));
            if (l > 0) { on[j] = __builtin_nontemporal_load((const u32x2*)(O + (size_t)rr * DM + col)); gtn[j] = *(const f32x4*)(gate + col); }
            if (l < DEPTH) { shn[j] = *(const f32x4*)(mrow + col); scn[j] = *(const f32x4*)(mrow + 1024 + col); } } };
    if (r < nrows) prefetch(r);
    for (; r < nrows; r += stride) {
        const bool is_ctx = r >= RL;
        f32x4 v[4], gt[4], sh[4], sc[4]; u32x2 ow[4];
#pragma unroll
        for (int j = 0; j < 4; ++j) { v[j] = vn[j]; ow[j] = on[j]; gt[j] = gtn[j]; sh[j] = shn[j]; sc[j] = scn[j]; }
        if (r + stride < nrows) prefetch(r + stride);
        if (l > 0) {
            f32x4 o[4]; float ss = 0.f;
#pragma unroll
            for (int j = 0; j < 4; ++j) { const u32x2 w = ow[j];
                o[j] = (f32x4){bf2f(w.x & 0xffffu), bf2f(w.x >> 16), bf2f(w.y & 0xffffu), bf2f(w.y >> 16)};
                ss += o[j][0] * o[j][0] + o[j][1] * o[j][1] + o[j][2] * o[j][2] + o[j][3] * o[j][3]; }
            const float rs = rsqrtf(wave_sum(ss) * (1.f / DM) + EPS);
            float* xo = is_ctx ? XC + (size_t)(r - RL) * DM : a->out + (size_t)r * DM;
#pragma unroll
            for (int j = 0; j < 4; ++j) { const int col = 4 * lane + 256 * j;
                v[j] += gt[j] * (o[j] * rs * gp4[j]); if (st) __builtin_nontemporal_store(v[j], (f32x4*)(xo + col)); }
        }
        if (l < DEPTH) {
            float ss = 0.f;
#pragma unroll
            for (int j = 0; j < 4; ++j) ss += v[j][0] * v[j][0] + v[j][1] * v[j][1] + v[j][2] * v[j][2] + v[j][3] * v[j][3];
            const float rs = rsqrtf(wave_sum(ss) * (1.f / DM) + EPS);
#pragma unroll
            for (int j = 0; j < 4; ++j) { const int col = 4 * lane + 256 * j;
                const f32x4 h = v[j] * rs * gpre4[j] * (sc[j] + 1.f) + sh[j]; u32x2 w; w.x = cvt_pk_bf16(h[0], h[1]); w.y = cvt_pk_bf16(h[2], h[3]);
                if (st) *(u32x2*)(H + (size_t)r * DM + col) = w; }
        }
    }
}

__device__ __forceinline__ void ext_unit(KA a, int l, int u) {
    const int tid = TIDX(), wave = tid >> 6, lane = tid & 63, fr = lane & 15, fq = lane >> 4;
    const bf16_t* H = (const bf16_t*)(a->ws + WS_H); const bf16_t* We = (const bf16_t*)(a->ws + WS_WEXT) + (size_t)l * 16 * DM; float* EXT = (float*)(a->ws + WS_EXT);
    const int row0 = u * 256 + wave * 32;
    f32x4 acc[2] = {(f32x4){0.f, 0.f, 0.f, 0.f}, (f32x4){0.f, 0.f, 0.f, 0.f}};
    const bf16_t* ap0 = H + (size_t)(row0 + fr) * DM + fq * 8; const bf16_t* ap1 = ap0 + 16 * DM; const bf16_t* bp = We + (size_t)fr * DM + fq * 8;
#pragma unroll 8
    for (int ks = 0; ks < 32; ++ks) { const bf16x8 b = *(const bf16x8*)(bp + ks * 32), a0 = *(const bf16x8*)(ap0 + ks * 32), a1 = *(const bf16x8*)(ap1 + ks * 32);
        acc[0] = __builtin_amdgcn_mfma_f32_16x16x32_bf16(a0, b, acc[0], 0, 0, 0); acc[1] = __builtin_amdgcn_mfma_f32_16x16x32_bf16(a1, b, acc[1], 0, 0, 0); }
#pragma unroll
    for (int mt = 0; mt < 2; ++mt)
#pragma unroll
        for (int r = 0; r < 4; ++r) EXT[(size_t)(row0 + 16 * mt + fq * 4 + r) * 16 + fr] = acc[mt][r];
}
__device__ __forceinline__ void phase_gemm(KA a, int l, bool is_out, LAS unsigned char* lds, int bid, int G) {
    const int M = (is_out && l == DEPTH - 1) ? RL : RT, N = is_out ? DM : PW;
    pg8::Gemm g;
    g.A = is_out ? (const bf16_t*)(a->ws + WS_P) : (const bf16_t*)(a->ws + WS_H);
    g.Bt = is_out ? (const bf16_t*)(a->ws + WS_WOUT) + (size_t)l * DM * DM : (const bf16_t*)(a->ws + WS_WIN) + (size_t)l * PW * DM;
    g.M = M; g.N = N; g.K = DM; g.lda = is_out ? PW : DM; g.seg = is_out ? 1 : 0;
    pg8::StaticOrder S; S.init(M, N, G, bid);
    pg8::EpiBf16 E{is_out ? (bf16_t*)(a->ws + WS_O) : (bf16_t*)(a->ws + WS_P), N};
    pg8::gemm_phase<pg8::EpiBf16>(lds, g, S, E);
    if (!is_out) { const int nwg = (RT / 256) * (PW / 256), first = nwg % G;
        for (int u = (bid - first + G) % G; u < RT / 256; u += G) ext_unit(a, l, u); }
}

__device__ __forceinline__ void phase_sc(KA a, int l, int bid, int G, bool st = true) {
    bf16_t* P = (bf16_t*)(a->ws + WS_P); const float* cw = a->sc_conv_w + (size_t)l * 3 * 256;
    const int nrows = (l == DEPTH - 1) ? RL : RT;
    for (int it = bid * 512 + TIDX(); it < nrows * 32; it += G * 512) {
        const int r = it >> 5, c8 = (it & 31) * 8; const bool is_ctx = r >= RL; const int t = is_ctx ? ((r - RL) & 255) : (r & 2047), len = is_ctx ? TC : TL;
        bf16_t* row = P + (size_t)r * PW;
        float ch[3][8];
#pragma unroll
        for (int d = 0; d < 3; ++d) { const int tt = t + d - 1, tc = tt < 0 ? 0 : (tt >= len ? len - 1 : tt); const float mk = (tt == tc) ? 1.f : 0.f;
            const u32x4 cv = *(const u32x4*)(row + (ptrdiff_t)(tc - t) * PW + C_CC + c8), hv = *(const u32x4*)(row + (ptrdiff_t)(tc - t) * PW + C_CH + c8);
#pragma unroll
            for (int e = 0; e < 4; ++e) { ch[d][2 * e] = mk * bf2f(cv[e] & 0xffffu) * bf2f(hv[e] & 0xffffu); ch[d][2 * e + 1] = mk * bf2f(cv[e] >> 16) * bf2f(hv[e] >> 16); } }
        const u32x4 bv = *(const u32x4*)(row + C_CB + c8), zv = *(const u32x4*)(row + C_CZ + c8);
        float y[8];
#pragma unroll
        for (int e = 0; e < 8; ++e) { const float conv = cw[c8 + e] * ch[0][e] + cw[256 + c8 + e] * ch[1][e] + cw[512 + c8 + e] * ch[2][e];
            const float bb = bf2f((e & 1) ? (bv[e >> 1] >> 16) : (bv[e >> 1] & 0xffffu)), zz = bf2f((e & 1) ? (zv[e >> 1] >> 16) : (zv[e >> 1] & 0xffffu));
            y[e] = bb * conv * silu_f(zz); }
        u32x4 o; o.x = cvt_pk_bf16(y[0], y[1]); o.y = cvt_pk_bf16(y[2], y[3]); o.z = cvt_pk_bf16(y[4], y[5]); o.w = cvt_pk_bf16(y[6], y[7]);
        if (st) *(u32x4*)(row + C_CB + c8) = o;
    }
}
__device__ __forceinline__ void phase_sg1(KA a, int l, int bid, int G) {
    const int wave = TIDX() >> 6, lane = TIDX() & 63;
    const bf16_t* P = (const bf16_t*)(a->ws + WS_P); float* SGV = (float*)(a->ws + WS_SGV);
    const int nrows = (l == DEPTH - 1) ? RL : RT;
    for (int r = bid * 8 + wave; r < nrows; r += G * 8) {
        const u32x2 w = *(const u32x2*)(P + (size_t)r * PW + C_SV + 4 * lane);
        f32x4 v = (f32x4){gelu_f(bf2f(w.x & 0xffffu)), gelu_f(bf2f(w.x >> 16)), gelu_f(bf2f(w.y & 0xffffu)), gelu_f(bf2f(w.y >> 16))};
        const float mu = wave_sum(v[0] + v[1] + v[2] + v[3]) * (1.f / 256.f); v = v - mu;
        const float var = wave_sum(v[0] * v[0] + v[1] * v[1] + v[2] * v[2] + v[3] * v[3]) * (1.f / 256.f);
        *(f32x4*)(SGV + (size_t)r * 256 + 4 * lane) = v * rsqrtf(var + EPS);
    }
}
__device__ __forceinline__ void phase_sg2(KA a, int l, LAS unsigned char* lds, int bid, int G) {
    const int tid = TIDX(); bf16_t* P = (bf16_t*)(a->ws + WS_P); const float* SGV = (const float*)(a->ws + WS_SGV);
    LAS float* sv = (LAS float*)lds;
    const int nch = (l == DEPTH - 1) ? 16 : 18;
    for (int it = bid; it < NB * nch; it += G) {
        const int b = it / nch, c = it % nch, base = c < 16 ? b * TL + c * 128 : RL + b * TC + (c - 16) * 128;
        __syncthreads();
        for (int i = tid; i < 128 * 64; i += 512) *(LAS f32x4*)(sv + i * 4) = *(const f32x4*)(SGV + (size_t)base * 256 + i * 4);
        __syncthreads();
        const int ch = tid & 255, h = ch >> 6, i0 = (tid >> 8) * 64;
        const float* W = a->sg_w + ((size_t)l * 4 + h) * 128 * 128; const float* bs = a->sg_b + ((size_t)l * 4 + h) * 128;
        for (int i = i0; i < i0 + 64; ++i) {
            float s = bs[i]; const float* wr = W + (size_t)i * 128;
#pragma unroll 16
            for (int j = 0; j < 128; ++j) s += wr[j] * sv[j * 256 + ch];
            bf16_t* row = P + (size_t)(base + i) * PW;
            const float u = bf2f(row[C_SU + ch]), z = bf2f(row[C_SZ + ch]);
            row[C_SU + ch] = (bf16_t)f2bf(gelu_f(u) * s * silu_f(z));
        }
    }
}
__device__ __forceinline__ void phase_gdn_prep(KA a, int l, int bid, int G) {
    const int wave = TIDX() >> 6, lane = TIDX() & 63;
    const bf16_t* P = (const bf16_t*)(a->ws + WS_P); const float* EXT = (const float*)(a->ws + WS_EXT);
    bf16_t* GQ = (bf16_t*)(a->ws + WS_GQ); bf16_t* GK = (bf16_t*)(a->ws + WS_GK); bf16_t* GV = (bf16_t*)(a->ws + WS_GV); float* GB = (float*)(a->ws + WS_GB);
    const float* cw = a->gdn_conv_w + (size_t)l * 3 * 768;
    for (int it = bid * 8 + wave; it < RT * 4; it += G * 8) {
        const int r = it >> 2, h = it & 3, chn = h * 64 + lane; const bool is_ctx = r >= RL; const int t = is_ctx ? ((r - RL) & 255) : (r & 2047), len = is_ctx ? TC : TL;
        const bf16_t* row = P + (size_t)r * PW;
        float q = 0.f, k = 0.f, v = 0.f;
#pragma unroll
        for (int d = 0; d < 3; ++d) { const int tt = t + d - 1; if (tt >= 0 && tt < len) { const bf16_t* rp = row + (ptrdiff_t)(d - 1) * PW;
            q += cw[d * 768 + chn] * bf2f(rp[C_GQ + chn]); k += cw[d * 768 + 256 + chn] * bf2f(rp[C_GK + chn]); v += cw[d * 768 + 512 + chn] * bf2f(rp[C_GV + chn]); } }
        q = silu_f(q); k = silu_f(k); v = silu_f(v);
        const float qs = rsqrtf(wave_sum(q * q) + EPS), ksn = rsqrtf(wave_sum(k * k) + EPS);
        GQ[(size_t)r * 256 + chn] = (bf16_t)f2bf(q * qs * 0.125f); GK[(size_t)r * 256 + chn] = (bf16_t)f2bf(k * ksn); GV[(size_t)r * 256 + chn] = (bf16_t)f2bf(v);
        if (lane < 4) { const int dir = lane & 1; const float e = EXT[(size_t)r * 16 + (lane >> 1) * 8 + dir * 4 + h]; float o;
            if (lane < 2) o = -__expf(a->gdn_a_log[(l * 2 + dir) * 4 + h]) * softplus_f(e + a->gdn_dt_bias[(l * 2 + dir) * 4 + h]); else o = sigmoid_f(e);
            GB[((size_t)r * 4 + h) * 4 + lane] = o; }
    }
}
__device__ __forceinline__ void phase_gdn_rec(KA a, int l, LAS unsigned char* lds, int bid, int G) {
    const int wave = TIDX() >> 6, lane = TIDX() & 63;
    const bf16_t* GQ = (const bf16_t*)(a->ws + WS_GQ); const bf16_t* GK = (const bf16_t*)(a->ws + WS_GK); const bf16_t* GV = (const bf16_t*)(a->ws + WS_GV); const float* GB = (const float*)(a->ws + WS_GB);
    float* OG = (float*)(a->ws + WS_OG);
    LAS float* qk = (LAS float*)lds + wave * 128;
    for (int ch = bid * 8 + wave; ch < NB * 4 * 2; ch += G * 8) {
        const int b = ch >> 3, h = (ch >> 1) & 3, dir = ch & 1;
        float S[64];
#pragma unroll
        for (int d = 0; d < 64; ++d) S[d] = 0.f;
        float* og = OG + (size_t)dir * RT * 256;
        auto sidx = [&](int i) { return dir == 0 ? i : (i < TC ? TC - 1 - i : (TC + TL - 1) - (i - TC)); };
        int r = seq_row(b, sidx(0));
        float qn = bf2f(GQ[(size_t)r * 256 + h * 64 + lane]), kn = bf2f(GK[(size_t)r * 256 + h * 64 + lane]), vn = bf2f(GV[(size_t)r * 256 + h * 64 + lane]);
        float gn = GB[((size_t)r * 4 + h) * 4 + dir], bn = GB[((size_t)r * 4 + h) * 4 + 2 + dir];
        for (int i = 0; i < TC + TL; ++i) {
            const float q = qn, k = kn, v = vn, g = gn, be = bn; const int rc = r;
            if (i + 1 < TC + TL) { r = seq_row(b, sidx(i + 1));
                qn = bf2f(GQ[(size_t)r * 256 + h * 64 + lane]); kn = bf2f(GK[(size_t)r * 256 + h * 64 + lane]); vn = bf2f(GV[(size_t)r * 256 + h * 64 + lane]);
                gn = GB[((size_t)r * 4 + h) * 4 + dir]; bn = GB[((size_t)r * 4 + h) * 4 + 2 + dir]; }
            qk[lane] = q; qk[64 + lane] = k;
            asm volatile("s_waitcnt lgkmcnt(0)" ::: "memory");
            const float dec = __expf(g); float kS = 0.f;
#pragma unroll
            for (int d4 = 0; d4 < 16; ++d4) { const f32x4 k4 = *(const LAS f32x4*)(qk + 64 + d4 * 4);
#pragma unroll
                for (int e = 0; e < 4; ++e) { S[d4 * 4 + e] *= dec; kS += k4[e] * S[d4 * 4 + e]; } }
            const float delta = be * (v - kS); float o = 0.f;
#pragma unroll
            for (int d4 = 0; d4 < 16; ++d4) { const f32x4 k4 = *(const LAS f32x4*)(qk + 64 + d4 * 4), q4 = *(const LAS f32x4*)(qk + d4 * 4);
#pragma unroll
                for (int e = 0; e < 4; ++e) { S[d4 * 4 + e] += k4[e] * delta; o += q4[e] * S[d4 * 4 + e]; } }
            og[(size_t)rc * 256 + h * 64 + lane] = o;
            asm volatile("s_waitcnt lgkmcnt(0)" ::: "memory");
        }
    }
}
__device__ __forceinline__ void phase_gdn_fin(KA a, int l, int bid, int G) {
    const int wave = TIDX() >> 6, lane = TIDX() & 63;
    bf16_t* P = (bf16_t*)(a->ws + WS_P); const float* OG = (const float*)(a->ws + WS_OG);
    const int nrows = (l == DEPTH - 1) ? RL : RT; const float ng = a->gdn_norm_g[l * 64 + lane];
    for (int it = bid * 8 + wave; it < nrows * 4; it += G * 8) {
        const int r = it >> 2, h = it & 3; const size_t oi = (size_t)r * 256 + h * 64 + lane;
        const float o = OG[oi] + OG[(size_t)RT * 256 + oi];
        const float rs = rsqrtf(wave_sum(o * o) * (1.f / 64.f) + EPS);
        bf16_t* zp = P + (size_t)r * PW + C_GZ + h * 64 + lane;
        *zp = (bf16_t)f2bf(o * rs * ng * silu_f(bf2f(*zp)));
    }
}
__device__ __forceinline__ void phase_ret_rec(KA a, int l, LAS unsigned char* lds, int bid, int G) {
    const int wave = TIDX() >> 6, lane = TIDX() & 63;
    const bf16_t* P = (const bf16_t*)(a->ws + WS_P); float* RO = (float*)(a->ws + WS_OG); const float* rope = (const float*)(a->ws + WS_ROPE);
    LAS float* qk = (LAS float*)lds + wave * 128;
    for (int ch = bid * 8 + wave; ch < NB * 4 * 2; ch += G * 8) {
        const int b = ch >> 3, h = (ch >> 1) & 3, dir = ch & 1;
        const float gamma = 1.f - exp2f(-5.f - (float)h);
        float S[64];
#pragma unroll
        for (int d = 0; d < 64; ++d) S[d] = 0.f;
        float* ro = RO + (size_t)dir * RT * 256;
        auto sidx = [&](int i) { return dir == 0 ? i : (i < TC ? TC - 1 - i : (TC + TL - 1) - (i - TC)); };
        const int f = lane & 15; const bool hi = (lane & 16) != 0, colhalf = lane >= 32;
        int s = sidx(0), r = seq_row(b, s);
        float qn = bf2f(P[(size_t)r * PW + C_RQ + h * 64 + lane]), kn = bf2f(P[(size_t)r * PW + C_RK + h * 64 + lane]), vn = bf2f(P[(size_t)r * PW + C_RV + h * 64 + lane]);
        for (int i = 0; i < TC + TL; ++i) {
            float q = qn, k = kn; const float v = vn; const int rc = r, sc = s;
            if (i + 1 < TC + TL) { s = sidx(i + 1); r = seq_row(b, s);
                qn = bf2f(P[(size_t)r * PW + C_RQ + h * 64 + lane]); kn = bf2f(P[(size_t)r * PW + C_RK + h * 64 + lane]); vn = bf2f(P[(size_t)r * PW + C_RV + h * 64 + lane]); }
            if (sc >= TC) { const int t = sc - TC, pos = colhalf ? (t & 63) : (t >> 6); const float cs = rope[pos * 16 + f], sn = rope[1024 + pos * 16 + f];
                const float qp = __shfl_xor(q, 16), kp = __shfl_xor(k, 16);
                q = hi ? (qp * sn + q * cs) : (q * cs - qp * sn); k = hi ? (kp * sn + k * cs) : (k * cs - kp * sn); }
            k *= 0.125f;
            qk[lane] = q; qk[64 + lane] = k;
            asm volatile("s_waitcnt lgkmcnt(0)" ::: "memory");
            float o = 0.f;
#pragma unroll
            for (int d4 = 0; d4 < 16; ++d4) { const f32x4 k4 = *(const LAS f32x4*)(qk + 64 + d4 * 4), q4 = *(const LAS f32x4*)(qk + d4 * 4);
#pragma unroll
                for (int e = 0; e < 4; ++e) { S[d4 * 4 + e] = gamma * S[d4 * 4 + e] + k4[e] * v; o += q4[e] * S[d4 * 4 + e]; } }
            ro[(size_t)rc * 256 + h * 64 + lane] = o;
            asm volatile("s_waitcnt lgkmcnt(0)" ::: "memory");
        }
    }
}
__device__ __forceinline__ void phase_ret_fin(KA a, int l, int bid, int G) {
    const int wave = TIDX() >> 6, lane = TIDX() & 63;
    bf16_t* P = (bf16_t*)(a->ws + WS_P); const float* RO = (const float*)(a->ws + WS_OG);
    const int nrows = (l == DEPTH - 1) ? RL : RT;
    for (int it = bid * 8 + wave; it < nrows * 4; it += G * 8) {
        const int r = it >> 2, h = it & 3; const size_t oi = (size_t)r * 256 + h * 64 + lane;
        float o = RO[oi] + RO[(size_t)RT * 256 + oi];
        const float mu = wave_sum(o) * (1.f / 64.f); o -= mu;
        const float rs = rsqrtf(wave_sum(o * o) * (1.f / 64.f) + EPS);
        const float z = bf2f(P[(size_t)r * PW + C_RZ + h * 64 + lane]);
        P[(size_t)r * PW + C_RQ + h * 64 + lane] = (bf16_t)f2bf(o * rs * a->ret_norm_g[l * 256 + h * 64 + lane] * silu_f(z));
    }
}

__device__ __forceinline__ void unpack8(const u32x4 w, float* o) {
#pragma unroll
    for (int e = 0; e < 4; ++e) { o[2 * e] = bf2f(w[e] & 0xffffu); o[2 * e + 1] = bf2f(w[e] >> 16); }
}
__device__ __forceinline__ void rot8(const bf16_t* hrow, int g, bool rot, int t, const float* rope, float* out) {
    const u32x4 wo = *(const u32x4*)(hrow + 8 * g), wp = *(const u32x4*)(hrow + 8 * (g ^ 2));
    const int tt = t & 2047, pos = (g >> 2) ? (tt & 63) : (tt >> 6), f0 = 8 * (g & 1); const bool hi = (g & 2) != 0;
    const f32x4 c0 = *(const f32x4*)(rope + pos * 16 + f0), c1 = *(const f32x4*)(rope + pos * 16 + f0 + 4), s0 = *(const f32x4*)(rope + 1024 + pos * 16 + f0), s1 = *(const f32x4*)(rope + 1024 + pos * 16 + f0 + 4);
    float p[8]; unpack8(wo, out); unpack8(wp, p);
#pragma unroll
    for (int j = 0; j < 8; ++j) { const float cs = j < 4 ? c0[j & 3] : c1[j & 3], sn = j < 4 ? s0[j & 3] : s1[j & 3]; const float rv = hi ? (p[j] * sn + out[j] * cs) : (out[j] * cs - p[j] * sn); out[j] = rot ? rv : out[j]; }
}
__device__ __forceinline__ int ret_row0(int b, int c) { return c < 2 ? RL + b * TC + c * 128 : b * TL + (c - 2) * 128; }
constexpr int TS = 272, RS = 144;

__device__ __forceinline__ void phase_ret_kv(KA a, int l, LAS unsigned char* lds, int bid, int G) {
    const int tid = TIDX(), wave = tid >> 6, lane = tid & 63, fr = lane & 15, fq = lane >> 4;
    const bf16_t* P = (const bf16_t*)(a->ws + WS_P); const float* rope = (const float*)(a->ws + WS_ROPE); bf16_t* KV = (bf16_t*)(a->ws + WS_KV);
    LAS unsigned char* kTf = lds; LAS unsigned char* kTb = lds + 64 * TS; LAS unsigned char* vT = lds + 128 * TS;
    for (int u = G - 1 - bid; u < NB * 18 * 4; u += G) {
        const int h = u & 3, c = (u >> 2) % 18, b = (u >> 2) / 18, row0 = ret_row0(b, c); const bool rot = c >= 2;
        const float lg = log2f(1.f - exp2f(-5.f - (float)h));
        __syncthreads();
        { const int g = wave, pp = lane, p0 = 2 * pp;
          float k0[8], k1[8], v0[8], v1[8];
          const bf16_t* r0 = P + (size_t)(row0 + p0) * PW + h * 64; const bf16_t* r1 = r0 + PW;
          rot8(r0 + C_RK, g, rot, (c - 2) * 128 + p0, rope, k0); rot8(r1 + C_RK, g, rot, (c - 2) * 128 + p0 + 1, rope, k1);
          unpack8(*(const u32x4*)(r0 + C_RV + 8 * g), v0); unpack8(*(const u32x4*)(r1 + C_RV + 8 * g), v1);
          const float wf0 = 0.125f * exp2f(lg * (float)(127 - p0)), wf1 = 0.125f * exp2f(lg * (float)(126 - p0)), wb0 = 0.125f * exp2f(lg * (float)p0), wb1 = 0.125f * exp2f(lg * (float)(p0 + 1));
#pragma unroll
          for (int j = 0; j < 8; ++j) { const int d = 8 * g + j;
              *(LAS unsigned*)(kTf + d * TS + pp * 4) = cvt_pk_bf16(k0[j] * wf0, k1[j] * wf1);
              *(LAS unsigned*)(kTb + d * TS + pp * 4) = cvt_pk_bf16(k0[j] * wb0, k1[j] * wb1);
              *(LAS unsigned*)(vT + d * TS + pp * 4) = cvt_pk_bf16(v0[j], v1[j]); } }
        __syncthreads();
        { const int dir = wave >> 2, mt = wave & 3; LAS unsigned char* kT = dir ? kTb : kTf;
          bf16x8 af[4];
#pragma unroll
          for (int ks = 0; ks < 4; ++ks) af[ks] = *(const LAS bf16x8*)(kT + (16 * mt + fr) * TS + (ks * 32 + fq * 8) * 2);
          bf16_t* dst = KV + ((size_t)u * 2 + dir) * 4096;
#pragma unroll
          for (int nt = 0; nt < 4; ++nt) { f32x4 acc = (f32x4){0.f, 0.f, 0.f, 0.f};
#pragma unroll
              for (int ks = 0; ks < 4; ++ks) { const bf16x8 bfr = *(const LAS bf16x8*)(vT + (16 * nt + fr) * TS + (ks * 32 + fq * 8) * 2); acc = __builtin_amdgcn_mfma_f32_16x16x32_bf16(af[ks], bfr, acc, 0, 0, 0); }
              u32x2 w; w.x = cvt_pk_bf16(acc[0], acc[1]); w.y = cvt_pk_bf16(acc[2], acc[3]);
              *(u32x2*)(dst + (16 * nt + fr) * 64 + 16 * mt + fq * 4) = w; } }
    }
}
__device__ __forceinline__ void phase_ret_out(KA a, int l, LAS unsigned char* lds, int bid, int G, int u_lo, int u_hi, bool st = true) {
    const int tid = TIDX(), wave = tid >> 6, lane = tid & 63, fr = lane & 15, fq = lane >> 4;
    bf16_t* P = (bf16_t*)(a->ws + WS_P); const float* rope = (const float*)(a->ws + WS_ROPE); const bf16_t* KV = (const bf16_t*)(a->ws + WS_KV);
    LAS unsigned char* qL = lds; LAS unsigned char* kL = lds + 128 * RS; LAS unsigned char* vT = lds + 256 * RS; LAS unsigned char* sF = vT + 64 * TS; LAS unsigned char* sB = sF + 64 * RS;
    LAS float* oL = (LAS float*)(sB + 64 * RS) + wave * (16 * 68);
    const int c_lo = (l == DEPTH - 1) ? 2 : 0, ncu = 18 - c_lo;
    for (int u = u_lo + bid; u < u_hi; u += G) {
        const int h = u & 3, c = c_lo + (u >> 2) % ncu, b = (u >> 2) / ncu, row0 = ret_row0(b, c); const bool rot = c >= 2;
        const float lg = log2f(1.f - exp2f(-5.f - (float)h));
        __syncthreads();
#pragma unroll
        for (int it = 0; it < 2; ++it) { const int item = tid + it * 512, p = item >> 3, g = item & 7; float q8[8], k8[8];
            const bf16_t* rp = P + (size_t)(row0 + p) * PW + h * 64;
            rot8(rp + C_RQ, g, rot, (c - 2) * 128 + p, rope, q8); rot8(rp + C_RK, g, rot, (c - 2) * 128 + p, rope, k8);
            u32x4 w; w.x = cvt_pk_bf16(q8[0], q8[1]); w.y = cvt_pk_bf16(q8[2], q8[3]); w.z = cvt_pk_bf16(q8[4], q8[5]); w.w = cvt_pk_bf16(q8[6], q8[7]);
            *(LAS u32x4*)(qL + p * RS + g * 16) = w;
            w.x = cvt_pk_bf16(k8[0] * 0.125f, k8[1] * 0.125f); w.y = cvt_pk_bf16(k8[2] * 0.125f, k8[3] * 0.125f); w.z = cvt_pk_bf16(k8[4] * 0.125f, k8[5] * 0.125f); w.w = cvt_pk_bf16(k8[6] * 0.125f, k8[7] * 0.125f);
            *(LAS u32x4*)(kL + p * RS + g * 16) = w; }
        { const int g = wave, pp = lane; const bf16_t* r0 = P + (size_t)(row0 + 2 * pp) * PW + C_RV + h * 64 + 8 * g;
          const u32x4 w0 = *(const u32x4*)r0, w1 = *(const u32x4*)(r0 + PW);
#pragma unroll
          for (int j = 0; j < 8; ++j) { const unsigned lo = (j & 1) ? (w0[j >> 1] >> 16) : (w0[j >> 1] & 0xffffu), hi2 = (j & 1) ? (w1[j >> 1] >> 16) : (w1[j >> 1] & 0xffffu);
              *(LAS unsigned*)(vT + (8 * g + j) * TS + pp * 4) = lo | (hi2 << 16); } }
        u32x4 zpre[2];
#pragma unroll
        for (int it = 0; it < 2; ++it) { const int item = lane + 64 * it; zpre[it] = *(const u32x4*)(P + (size_t)(row0 + 16 * wave + (item >> 3)) * PW + h * 64 + 8 * (item & 7) + C_RZ); }
        { const int e = tid >> 3, d0 = (tid & 7) * 8; const float lc = lg * 128.f;
          float sf[8], sb[8];
#pragma unroll
          for (int j = 0; j < 8; ++j) { sf[j] = 0.f; sb[j] = 0.f; }
          const int obc = c < 2 ? 1 - c : 19 - c;
          const bf16_t* kvb = KV + ((size_t)((b * 18) * 4 + h) * 2) * 4096 + e * 64 + d0;
#pragma unroll 1
          for (int jb = 0; jb < 18; jb += 6) { u32x4 tf[6], tb[6];
#pragma unroll
              for (int jj = 0; jj < 6; ++jj) { tf[jj] = *(const u32x4*)(kvb + (size_t)(jb + jj) * 32768); tb[jj] = *(const u32x4*)(kvb + (size_t)(jb + jj) * 32768 + 4096); }
#pragma unroll
              for (int jj = 0; jj < 6; ++jj) { const int j = jb + jj, obj = j < 2 ? 1 - j : 19 - j;
                  const float wf = j < c ? exp2f(lc * (float)(c - 1 - j)) : 0.f, wb = obj < obc ? exp2f(lc * (float)(obc - 1 - obj)) : 0.f;
                  float t8[8]; unpack8(tf[jj], t8);
#pragma unroll
                  for (int x = 0; x < 8; ++x) sf[x] += wf * t8[x];
                  unpack8(tb[jj], t8);
#pragma unroll
                  for (int x = 0; x < 8; ++x) sb[x] += wb * t8[x]; } }
          u32x4 w; w.x = cvt_pk_bf16(sf[0], sf[1]); w.y = cvt_pk_bf16(sf[2], sf[3]); w.z = cvt_pk_bf16(sf[4], sf[5]); w.w = cvt_pk_bf16(sf[6], sf[7]);
          *(LAS u32x4*)(sF + e * RS + d0 * 2) = w;
          w.x = cvt_pk_bf16(sb[0], sb[1]); w.y = cvt_pk_bf16(sb[2], sb[3]); w.z = cvt_pk_bf16(sb[4], sb[5]); w.w = cvt_pk_bf16(sb[6], sb[7]);
          *(LAS u32x4*)(sB + e * RS + d0 * 2) = w; }
        __syncthreads();
        const int i0 = 16 * wave;
        bf16x8 qf[2];
#pragma unroll
        for (int ks = 0; ks < 2; ++ks) qf[ks] = *(const LAS bf16x8*)(qL + (i0 + fr) * RS + (ks * 32 + fq * 8) * 2);
        bf16x8 pf[4];
#pragma unroll
        for (int t = 0; t < 4; ++t) { f32x4 s2[2];
#pragma unroll
            for (int hh = 0; hh < 2; ++hh) { const int jt = 2 * t + hh; f32x4 acc = (f32x4){0.f, 0.f, 0.f, 0.f};
#pragma unroll
                for (int ks = 0; ks < 2; ++ks) { const bf16x8 kf = *(const LAS bf16x8*)(kL + (16 * jt + fr) * RS + (ks * 32 + fq * 8) * 2); acc = __builtin_amdgcn_mfma_f32_16x16x32_bf16(kf, qf[ks], acc, 0, 0, 0); }
#pragma unroll
                for (int r = 0; r < 4; ++r) { const int jj = 16 * jt + 4 * fq + r, ii = i0 + fr, df = ii > jj ? ii - jj : jj - ii; acc[r] *= exp2f(lg * (float)df) * (df == 0 ? 2.f : 1.f); }
                s2[hh] = acc; }
            u32x4 w; w.x = cvt_pk_bf16(s2[0][0], s2[0][1]); w.y = cvt_pk_bf16(s2[0][2], s2[0][3]); w.z = cvt_pk_bf16(s2[1][0], s2[1][1]); w.w = cvt_pk_bf16(s2[1][2], s2[1][3]);
            pf[t] = __builtin_bit_cast(bf16x8, w); }
        float dq[4], db[4];
#pragma unroll
        for (int r = 0; r < 4; ++r) { const int pi = i0 + 4 * fq + r; dq[r] = exp2f(lg * (float)(pi + 1)); db[r] = exp2f(lg * (float)(128 - pi)); }
        f32x4 o[4]; float sum[4] = {0.f, 0.f, 0.f, 0.f};
#pragma unroll
        for (int nt = 0; nt < 4; ++nt) { f32x4 acc = (f32x4){0.f, 0.f, 0.f, 0.f}, af = acc, ab = acc;
#pragma unroll
            for (int t = 0; t < 4; ++t) { const LAS unsigned char* vp = vT + (16 * nt + fr) * TS + (32 * t + 4 * fq) * 2;
                const u32x2 lo = *(const LAS u32x2*)vp, hi2 = *(const LAS u32x2*)(vp + 32); const u32x4 w = (u32x4){lo.x, lo.y, hi2.x, hi2.y};
                acc = __builtin_amdgcn_mfma_f32_16x16x32_bf16(pf[t], __builtin_bit_cast(bf16x8, w), acc, 0, 0, 0); }
#pragma unroll
            for (int ks = 0; ks < 2; ++ks) { const bf16x8 s1 = *(const LAS bf16x8*)(sF + (16 * nt + fr) * RS + (ks * 32 + fq * 8) * 2), s2 = *(const LAS bf16x8*)(sB + (16 * nt + fr) * RS + (ks * 32 + fq * 8) * 2);
                af = __builtin_amdgcn_mfma_f32_16x16x32_bf16(qf[ks], s1, af, 0, 0, 0); ab = __builtin_amdgcn_mfma_f32_16x16x32_bf16(qf[ks], s2, ab, 0, 0, 0); }
#pragma unroll
            for (int r = 0; r < 4; ++r) { acc[r] += af[r] * dq[r] + ab[r] * db[r]; sum[r] += acc[r]; }
            o[nt] = acc; }
        float mu[4], rs[4];
#pragma unroll
        for (int r = 0; r < 4; ++r) { float sv = sum[r]; sv += __shfl_xor(sv, 1); sv += __shfl_xor(sv, 2); sv += __shfl_xor(sv, 4); sv += __shfl_xor(sv, 8); mu[r] = sv * (1.f / 64.f);
            float q2 = 0.f;
#pragma unroll
            for (int nt = 0; nt < 4; ++nt) { const float dd = o[nt][r] - mu[r]; q2 += dd * dd; }
            q2 += __shfl_xor(q2, 1); q2 += __shfl_xor(q2, 2); q2 += __shfl_xor(q2, 4); q2 += __shfl_xor(q2, 8); rs[r] = rsqrtf(q2 * (1.f / 64.f) + EPS); }
#pragma unroll
        for (int nt = 0; nt < 4; ++nt)
#pragma unroll
            for (int r = 0; r < 4; ++r) oL[(4 * fq + r) * 68 + 16 * nt + fr] = (o[nt][r] - mu[r]) * rs[r];
        __syncthreads();
#pragma unroll
        for (int it = 0; it < 2; ++it) { const int item = lane + 64 * it, rr = item >> 3, g = item & 7;
            const f32x4 x0 = *(const LAS f32x4*)(oL + rr * 68 + 8 * g), x1 = *(const LAS f32x4*)(oL + rr * 68 + 8 * g + 4);
            bf16_t* rp = P + (size_t)(row0 + i0 + rr) * PW + h * 64 + 8 * g; float z8[8]; unpack8(zpre[it], z8);
            const float* ng = a->ret_norm_g + l * 256 + h * 64 + 8 * g; const f32x4 g0 = *(const f32x4*)ng, g1 = *(const f32x4*)(ng + 4);
            float y[8];
#pragma unroll
            for (int j = 0; j < 8; ++j) y[j] = (j < 4 ? x0[j & 3] * g0[j & 3] : x1[j & 3] * g1[j & 3]) * silu_f(z8[j]);
            u32x4 w; w.x = cvt_pk_bf16(y[0], y[1]); w.y = cvt_pk_bf16(y[2], y[3]); w.z = cvt_pk_bf16(y[4], y[5]); w.w = cvt_pk_bf16(y[6], y[7]);
#if EXP_NOINPLACE
            *(u32x4*)((bf16_t*)(a->ws + WS_OG) + (size_t)(row0 + i0 + rr) * 256 + h * 64 + 8 * g) = w; }
#else
            if (st) *(u32x4*)(rp + C_RQ) = w; }
#endif
    }
}
__device__ __forceinline__ void phase_ret_copy(KA a, int l, int bid, int G) {
    bf16_t* P = (bf16_t*)(a->ws + WS_P); const bf16_t* Y = (const bf16_t*)(a->ws + WS_OG);
    const int nrows = (l == DEPTH - 1) ? RL : RT;
    for (int it = bid * 512 + TIDX(); it < nrows * 32; it += G * 512) { const int r = it >> 5, c8 = (it & 31) * 8;
        *(u32x4*)(P + (size_t)r * PW + C_RQ + c8) = *(const u32x4*)(Y + (size_t)r * 256 + c8); }
}

constexpr size_t WS_QN = WS_X, WS_KN = WS_X + 18 * MiB, WS_KNT = WS_X + 36 * MiB, WS_WN = WS_X + 54 * MiB, WS_UT = WS_X + 90 * MiB, WS_SOLD0 = WS_X + 126 * MiB,
                 WS_SOLD1 = 492 * MiB, WS_GC = 510 * MiB, WS_END2 = 512 * MiB;
__device__ __forceinline__ int P32(int c) { return ((c & 15) >> 2) * 8 + (c >> 4) * 4 + (c & 3); }
__device__ __forceinline__ int gdn_row0(int b, int c) { return c < 4 ? RL + b * TC + c * 64 : b * TL + (c - 4) * 64; }
__device__ __forceinline__ u32x4 pack8(const float* v) { u32x4 w; w.x = cvt_pk_bf16(v[0], v[1]); w.y = cvt_pk_bf16(v[2], v[3]); w.z = cvt_pk_bf16(v[4], v[5]); w.w = cvt_pk_bf16(v[6], v[7]); return w; }

template <int DIR>
__device__ __forceinline__ void gdn_solve(int lane, int hd, int half, int gub, LAS unsigned char* knL, LAS float* vL, LAS float* Lm, LAS float* DinvL, LAS float* btL, LAS float* egL, bf16_t* UT, bf16_t* WN) {
    const int hh = hd >> 1, fr = lane & 15, fq = lane >> 4;
    const int i0 = DIR ? 12 - 4 * fq : 4 * fq;
    auto ioff = [](int kb, int r) { return DIR ? 16 * (3 - kb) + (3 - r) : 16 * kb + r; };
    const LAS float* Lb = Lm + (hd * 64 + fr) * 64 + 4 * fq; const LAS float* bb = btL + hd * 64 + i0; const LAS float* eb = egL + hd * 64 + i0;
    const LAS float* vb = vL + (hh * 64 + i0) * 64 + fr; const LAS unsigned char* kb_ = knL + (hh * 64 + i0) * 144 + fr * 2;
    const LAS float* Db = DinvL + (hd * 64 + fr) * 16 + 4 * fq;
    f32x4 X[4][4];
#pragma unroll
    for (int kb = 0; kb < 4; ++kb) {
        f32x4 acc[4];
#pragma unroll
        for (int r = 0; r < 4; ++r) { const int io = ioff(kb, r); const float bt = bb[io], be = bt * eb[io];
#pragma unroll
            for (int nt = 0; nt < 4; ++nt) acc[nt][r] = half == 0 ? vb[io * 64 + 16 * nt] * bt : bf2f(*(const LAS bf16_t*)(kb_ + io * 144 + 32 * nt)) * be; }
#pragma unroll
        for (int m = 0; m < kb; ++m) { const f32x4 a4 = *(const LAS f32x4*)(Lb + (16 * kb) * 64 + 16 * m);
#pragma unroll
            for (int r = 0; r < 4; ++r)
#pragma unroll
                for (int nt = 0; nt < 4; ++nt) acc[nt] = __builtin_amdgcn_mfma_f32_16x16x4f32(-a4[r], X[m][nt][r], acc[nt], 0, 0, 0); }
        const f32x4 d4 = *(const LAS f32x4*)(Db + kb * 256);
#pragma unroll
        for (int nt = 0; nt < 4; ++nt) { f32x4 x = (f32x4){0.f, 0.f, 0.f, 0.f};
#pragma unroll
            for (int r = 0; r < 4; ++r) x = __builtin_amdgcn_mfma_f32_16x16x4f32(d4[r], acc[nt][r], x, 0, 0, 0);
            X[kb][nt] = x; } }
    const size_t gu2 = (size_t)(gub + hh) * 2 + DIR;
    if (half == 0) { bf16_t* dst = UT + gu2 * 4096 + (size_t)fr * 64 + i0 - (DIR ? 3 : 0) + (DIR ? 3 : 0);
#pragma unroll
        for (int kb = 0; kb < 4; ++kb)
#pragma unroll
            for (int nt = 0; nt < 4; ++nt) { const f32x4 x = X[kb][nt]; u32x2 w;
                if (DIR == 0) { w.x = cvt_pk_bf16(x[0], x[1]); w.y = cvt_pk_bf16(x[2], x[3]); } else { w.x = cvt_pk_bf16(x[3], x[2]); w.y = cvt_pk_bf16(x[1], x[0]); }
                *(u32x2*)(dst + nt * 1024 + (DIR ? 16 * (3 - kb) : 16 * kb)) = w; } }
    else { bf16_t* dst = WN + gu2 * 4096 + (size_t)i0 * 64 + (fr >> 2) * 8 + (fr & 3);
#pragma unroll
        for (int kb = 0; kb < 4; ++kb)
#pragma unroll
            for (int nt = 0; nt < 4; ++nt)
#pragma unroll
                for (int r = 0; r < 4; ++r) dst[ioff(kb, r) * 64 + 32 * (nt >> 1) + 4 * (nt & 1)] = (bf16_t)f2bf(-X[kb][nt][r]); }
}
__device__ __forceinline__ void phase_gdn_prep2(KA a, int l, LAS unsigned char* lds, int bid, int G) {
    const int tid = TIDX(), wave = tid >> 6, lane = tid & 63, fr = lane & 15, fq = lane >> 4;
    unsigned char* ws = a->ws; const bf16_t* P = (const bf16_t*)(ws + WS_P); const float* EXT = (const float*)(ws + WS_EXT);
    bf16_t* QN = (bf16_t*)(ws + WS_QN); bf16_t* KN = (bf16_t*)(ws + WS_KN); bf16_t* KNT = (bf16_t*)(ws + WS_KNT); bf16_t* WN = (bf16_t*)(ws + WS_WN); bf16_t* UT = (bf16_t*)(ws + WS_UT); float* GC = (float*)(ws + WS_GC);
    LAS unsigned char* knL = lds;
    LAS float* vL = (LAS float*)(lds + 18432);
    LAS float* Lm = (LAS float*)(lds + 51200);
    LAS float* gcL = (LAS float*)(lds + 116736); LAS float* btL = gcL + 256; LAS float* egL = gcL + 512;
    LAS float* DinvL = (LAS float*)(lds + 119808);
    const float* cw = a->gdn_conv_w + (size_t)l * 3 * 768;
    for (int u = bid; u < NB * 36 * 2; u += G) {
        const int hp = u & 1, c = (u >> 1) % 36, b = (u >> 1) / 36, row0 = gdn_row0(b, c); const bool is_ctx = c < 4;
        const int t0 = is_ctx ? c * 64 : (c - 4) * 64, len = is_ctx ? TC : TL; const int gub = ((b * 36 + c) * 4 + hp * 2);
        __syncthreads();
        {
            const int g = tid & 7, hh = (tid >> 3) & 1, h = hp * 2 + hh, chq = h * 64 + 8 * g; const int gu = gub + hh;
            float wq[3][8], wk[3][8], wv[3][8];
#pragma unroll
            for (int tap = 0; tap < 3; ++tap) { const float* cp = cw + tap * 768 + chq;
                const f32x4 a0 = *(const f32x4*)cp, a1 = *(const f32x4*)(cp + 4), b0 = *(const f32x4*)(cp + 256), b1 = *(const f32x4*)(cp + 260), c0 = *(const f32x4*)(cp + 512), c1 = *(const f32x4*)(cp + 516);
#pragma unroll
                for (int j = 0; j < 4; ++j) { wq[tap][j] = a0[j]; wq[tap][4 + j] = a1[j]; wk[tap][j] = b0[j]; wk[tap][4 + j] = b1[j]; wv[tap][j] = c0[j]; wv[tap][4 + j] = c1[j]; } }
#pragma unroll
            for (int it = 0; it < 2; ++it) { const int i = (tid >> 4) + 32 * it, t = t0 + i;
                u32x4 ldq[3], ldk[3], ldv[3]; float msk[3];
#pragma unroll
                for (int tap = 0; tap < 3; ++tap) { const int tt = t + tap - 1, tc = tt < 0 ? 0 : (tt >= len ? len - 1 : tt); msk[tap] = (tt == tc) ? 1.f : 0.f;
                    const bf16_t* rp = P + (size_t)(row0 + i + (tc - t)) * PW + chq;
                    ldq[tap] = *(const u32x4*)(rp + C_GQ); ldk[tap] = *(const u32x4*)(rp + C_GK); ldv[tap] = *(const u32x4*)(rp + C_GV); }
                float q8[8], k8[8], v8[8];
#pragma unroll
                for (int j = 0; j < 8; ++j) { q8[j] = 0.f; k8[j] = 0.f; v8[j] = 0.f; }
#pragma unroll
                for (int tap = 0; tap < 3; ++tap) { float x8[8]; const float mk = msk[tap];
                    unpack8(ldq[tap], x8);
#pragma unroll
                    for (int j = 0; j < 8; ++j) q8[j] += wq[tap][j] * mk * x8[j];
                    unpack8(ldk[tap], x8);
#pragma unroll
                    for (int j = 0; j < 8; ++j) k8[j] += wk[tap][j] * mk * x8[j];
                    unpack8(ldv[tap], x8);
#pragma unroll
                    for (int j = 0; j < 8; ++j) v8[j] += wv[tap][j] * mk * x8[j]; }
                float sq = 0.f, sk = 0.f;
#pragma unroll
                for (int j = 0; j < 8; ++j) { q8[j] = silu_f(q8[j]); k8[j] = silu_f(k8[j]); v8[j] = silu_f(v8[j]); sq += q8[j] * q8[j]; sk += k8[j] * k8[j]; }
                sq += __shfl_xor(sq, 1); sq += __shfl_xor(sq, 2); sq += __shfl_xor(sq, 4); sk += __shfl_xor(sk, 1); sk += __shfl_xor(sk, 2); sk += __shfl_xor(sk, 4);
                const float rq = rsqrtf(sq + EPS) * 0.125f, rk = rsqrtf(sk + EPS);
#pragma unroll
                for (int j = 0; j < 8; ++j) { q8[j] *= rq; k8[j] *= rk; }
                *(u32x4*)(QN + ((size_t)gu * 64 + i) * 64 + 8 * g) = pack8(q8);
                const u32x4 kw = pack8(k8);
                *(u32x4*)(KN + ((size_t)gu * 64 + i) * 64 + 8 * g) = kw;
                *(LAS u32x4*)(knL + (hh * 64 + i) * 144 + g * 16) = kw;
                *(LAS f32x4*)(vL + (hh * 64 + i) * 64 + 8 * g) = (f32x4){v8[0], v8[1], v8[2], v8[3]}; *(LAS f32x4*)(vL + (hh * 64 + i) * 64 + 8 * g + 4) = (f32x4){v8[4], v8[5], v8[6], v8[7]}; }
        }
        if (wave < 4) {
            const int hh = wave >> 1, dir = wave & 1, h = hp * 2 + hh, i = lane; const size_t row = (size_t)(row0 + i);
            const float av = EXT[row * 16 + dir * 4 + h], bv = EXT[row * 16 + 8 + dir * 4 + h];
            float gcum = -__expf(a->gdn_a_log[(l * 2 + dir) * 4 + h]) * softplus_f(av + a->gdn_dt_bias[(l * 2 + dir) * 4 + h]);
#pragma unroll
            for (int o = 1; o < 64; o <<= 1) { const float up = __shfl_up(gcum, o), dn = __shfl_down(gcum, o); if (dir == 0) { if (lane >= o) gcum += up; } else { if (lane + o < 64) gcum += dn; } }
            gcL[wave * 64 + i] = gcum; btL[wave * 64 + i] = sigmoid_f(bv); egL[wave * 64 + i] = __expf(gcum);
            GC[((size_t)(gub + hh) * 2 + dir) * 64 + i] = gcum;
        }
        __syncthreads();
        {
            const int hh = wave >> 2, it_ = wave & 3; LAS unsigned char* kb = knL + hh * 64 * 144;
            bf16x8 af[2];
#pragma unroll
            for (int ks = 0; ks < 2; ++ks) af[ks] = *(const LAS bf16x8*)(kb + (16 * it_ + fr) * 144 + (ks * 32 + fq * 8) * 2);
#pragma unroll
            for (int jt = 0; jt < 4; ++jt) { f32x4 acc = (f32x4){0.f, 0.f, 0.f, 0.f};
#pragma unroll
                for (int ks = 0; ks < 2; ++ks) { const bf16x8 bfr = *(const LAS bf16x8*)(kb + (16 * jt + fr) * 144 + (ks * 32 + fq * 8) * 2); acc = __builtin_amdgcn_mfma_f32_16x16x32_bf16(af[ks], bfr, acc, 0, 0, 0); }
                const int j = 16 * jt + fr;
#pragma unroll
                for (int dir = 0; dir < 2; ++dir) { const int hd = hh * 2 + dir; const float gj = gcL[hd * 64 + j];
#pragma unroll
                    for (int r = 0; r < 4; ++r) { const int i = 16 * it_ + 4 * fq + r; const bool valid = dir ? (i < j) : (i > j);
                        const float val = valid ? btL[hd * 64 + i] * acc[r] * __expf(gcL[hd * 64 + i] - gj) : 0.f;
                        const int p = dir ? 63 - i : i, q = dir ? 63 - j : j; Lm[(hd * 64 + p) * 64 + q] = val; } } }
#pragma unroll
            for (int it2 = 0; it2 < 2; ++it2) { const int item = tid + 512 * it2, hh2 = item >> 9, d = (item >> 3) & 63, tg = item & 7; float t8[8];
#pragma unroll
                for (int x = 0; x < 8; ++x) t8[x] = bf2f(*(const LAS bf16_t*)(knL + (hh2 * 64 + 8 * tg + x) * 144 + d * 2));
                const u32x4 kw2 = pack8(t8); bf16_t* kd = KNT + ((size_t)(gub + hh2) * 64 + d) * 64 + ((8 * tg) & 32) + P32((8 * tg) & 31);
                *(u32x2*)kd = (u32x2){kw2.x, kw2.y}; *(u32x2*)(kd + 8) = (u32x2){kw2.z, kw2.w}; }
        }
        __syncthreads();
        {
            if (tid < 256) { const int hd = tid >> 6, kb = (tid >> 4) & 3, cidx = tid & 15; const LAS float* Dg = Lm + (hd * 64 + 16 * kb) * 64 + 16 * kb;
                float y[16];
#pragma unroll
                for (int r = 0; r < 16; ++r) y[r] = 0.f;
#pragma unroll
                for (int rb = 0; rb < 16; rb += 8) {
                    f32x4 dr[8][4];
#pragma unroll
                    for (int r = 0; r < 8; ++r)
#pragma unroll
                        for (int q4 = 0; q4 < (rb + r + 3) / 4; ++q4) dr[r][q4] = *(const LAS f32x4*)(Dg + (rb + r) * 64 + 4 * q4);
#pragma unroll
                    for (int r = 0; r < 8; ++r) { const int rr = rb + r; float acc = (rr == cidx) ? 1.f : 0.f;
#pragma unroll
                        for (int q4 = 0; q4 < (rr + 3) / 4; ++q4) acc -= dr[r][q4][0] * y[4 * q4] + dr[r][q4][1] * y[4 * q4 + 1] + dr[r][q4][2] * y[4 * q4 + 2] + dr[r][q4][3] * y[4 * q4 + 3];
                        y[rr] = acc; DinvL[((hd * 4 + kb) * 16 + rr) * 16 + cidx] = acc; } } }
        }
        __syncthreads();
        {
            const int w8 = __builtin_amdgcn_readfirstlane(tid >> 6);
            if ((w8 >> 1) & 1) gdn_solve<1>(lane, w8 >> 1, w8 & 1, gub, knL, vL, Lm, DinvL, btL, egL, UT, WN); else gdn_solve<0>(lane, w8 >> 1, w8 & 1, gub, knL, vL, Lm, DinvL, btL, egL, UT, WN);
        }
    }
}
__device__ __forceinline__ void phase_gdn_chain(KA a, int l, LAS unsigned char* lds, int bid, int G) {
    const int tid = TIDX(), wave = __builtin_amdgcn_readfirstlane(tid >> 6), lane = tid & 63, fr = lane & 15, fq = lane >> 4;
    unsigned char* ws = a->ws; const bf16_t* KNT = (const bf16_t*)(ws + WS_KNT); const bf16_t* WN = (const bf16_t*)(ws + WS_WN); bf16_t* UT = (bf16_t*)(ws + WS_UT); const float* GC = (const float*)(ws + WS_GC);
    constexpr int SLOT = 27904, OFF_KT = 9216, OFF_UT = 18432, OFF_GC = 27648, D = 5;
    for (int ch = bid; ch < NB * 8; ch += G) {
        const int b = ch >> 3, h = (ch >> 1) & 3, dir = ch & 1;
        auto chunk_of = [&](int k) { return dir == 0 ? k : (k < 4 ? 3 - k : 39 - k); };
        __syncthreads();
        if (wave >= 4) {
            const int t = tid - 256;
            u32x4 st[6][6]; f32x4 sgc[6];
            auto issue = [&](int s_, int set) { const int c = chunk_of(s_); const size_t gu = (size_t)((b * 36 + c) * 4 + h), gu2 = gu * 2 + dir;
#pragma unroll
                for (int i = 0; i < 2; ++i) { const int q = t + 256 * i; st[set][i] = *(const u32x4*)(WN + gu2 * 4096 + q * 8); st[set][2 + i] = *(const u32x4*)(KNT + gu * 4096 + q * 8); st[set][4 + i] = *(const u32x4*)(UT + gu2 * 4096 + q * 8); }
                if (t < 16) sgc[set] = *(const f32x4*)(GC + gu2 * 64 + 4 * t); };
            auto put = [&](int s_, int set) { LAS unsigned char* sl = lds + (s_ & 1) * SLOT;
#pragma unroll
                for (int i = 0; i < 2; ++i) { const int q = t + 256 * i, off = (q >> 3) * 144 + (q & 7) * 16; *(LAS u32x4*)(sl + off) = st[set][i]; *(LAS u32x4*)(sl + OFF_KT + off) = st[set][2 + i]; *(LAS u32x4*)(sl + OFF_UT + off) = st[set][4 + i]; }
                if (t < 16) *(LAS f32x4*)(sl + OFF_GC + 16 * t) = sgc[set]; };
#pragma unroll
            for (int s_ = 0; s_ < D; ++s_) issue(s_, s_);
            put(0, 0);
            __syncthreads();
            for (int kk = 0; kk < 36; kk += 6) {
#pragma unroll
                for (int j = 0; j < 6; ++j) { const int k = kk + j;
                    if (k + D < 36) issue(k + D, (j + D) % 6);
                    if (k + 1 < 36) put(k + 1, (j + 1) % 6);
                    __syncthreads(); } }
        } else {
            const int n0 = 16 * wave;
            bf16_t* SOLD = (bf16_t*)(ws + (dir ? WS_SOLD1 : WS_SOLD0));
            f32x4 Sc[4]; u32x4 Sb[2];
#pragma unroll
            for (int m = 0; m < 4; ++m) Sc[m] = (f32x4){0.f, 0.f, 0.f, 0.f};
            Sb[0] = (u32x4){0, 0, 0, 0}; Sb[1] = Sb[0];
            __syncthreads();
            for (int k = 0; k < 36; ++k) {
                const int c = chunk_of(k); const size_t gu = (size_t)((b * 36 + c) * 4 + h), gu2 = gu * 2 + dir;
                const LAS unsigned char* sl = lds + (k & 1) * SLOT;
                u32x4 wn[4][2], kt[4][2]; u32x2 uu[4]; f32x4 gcv[2][2];
#pragma unroll
                for (int m = 0; m < 4; ++m) {
#pragma unroll
                    for (int ks = 0; ks < 2; ++ks) { wn[m][ks] = *(const LAS u32x4*)(sl + (16 * m + fr) * 144 + ks * 64 + fq * 16); kt[m][ks] = *(const LAS u32x4*)(sl + OFF_KT + (16 * m + fr) * 144 + ks * 64 + fq * 16); }
                    uu[m] = *(const LAS u32x2*)(sl + OFF_UT + (n0 + fr) * 144 + (16 * m + 4 * fq) * 2); }
#pragma unroll
                for (int ks = 0; ks < 2; ++ks) { gcv[ks][0] = *(const LAS f32x4*)(sl + OFF_GC + (32 * ks + 4 * fq) * 4); gcv[ks][1] = *(const LAS f32x4*)(sl + OFF_GC + (32 * ks + 16 + 4 * fq) * 4); }
                const float glast = *(const LAS float*)(sl + OFF_GC + (dir ? 0 : 63) * 4);
                f32x4 vn[4];
#pragma unroll
                for (int m = 0; m < 4; ++m) { f32x4 acc = (f32x4){bf2f(uu[m].x & 0xffffu), bf2f(uu[m].x >> 16), bf2f(uu[m].y & 0xffffu), bf2f(uu[m].y >> 16)};
#pragma unroll
                    for (int ks = 0; ks < 2; ++ks) acc = __builtin_amdgcn_mfma_f32_16x16x32_bf16(__builtin_bit_cast(bf16x8, wn[m][ks]), __builtin_bit_cast(bf16x8, Sb[ks]), acc, 0, 0, 0);
                    vn[m] = acc; }
                bf16_t* vdst = UT + gu2 * 4096 + (size_t)(n0 + fr) * 64 + 4 * fq; bf16_t* sdst = SOLD + gu * 4096 + (size_t)(n0 + fr) * 64 + 4 * fq;
#pragma unroll
                for (int m = 0; m < 4; ++m) { u32x2 w; w.x = cvt_pk_bf16(vn[m][0], vn[m][1]); w.y = cvt_pk_bf16(vn[m][2], vn[m][3]); *(u32x2*)(vdst + m * 16) = w;
                    u32x2 s2; s2.x = (m & 1) ? Sb[m >> 1].z : Sb[m >> 1].x; s2.y = (m & 1) ? Sb[m >> 1].w : Sb[m >> 1].y; *(u32x2*)(sdst + m * 16) = s2; }
                u32x4 Vb[2];
#pragma unroll
                for (int ks = 0; ks < 2; ++ks) { f32x4 e0, e1;
#pragma unroll
                    for (int r = 0; r < 4; ++r) { e0[r] = vn[2 * ks][r] * __expf(glast - gcv[ks][0][r]); e1[r] = vn[2 * ks + 1][r] * __expf(glast - gcv[ks][1][r]); }
                    Vb[ks] = (u32x4){cvt_pk_bf16(e0[0], e0[1]), cvt_pk_bf16(e0[2], e0[3]), cvt_pk_bf16(e1[0], e1[1]), cvt_pk_bf16(e1[2], e1[3])}; }
                const float cd = __expf(glast);
#pragma unroll
                for (int m = 0; m < 4; ++m) { f32x4 acc = Sc[m] * cd;
#pragma unroll
                    for (int ks = 0; ks < 2; ++ks) acc = __builtin_amdgcn_mfma_f32_16x16x32_bf16(__builtin_bit_cast(bf16x8, kt[m][ks]), __builtin_bit_cast(bf16x8, Vb[ks]), acc, 0, 0, 0);
                    Sc[m] = acc; }
#pragma unroll
                for (int ks = 0; ks < 2; ++ks) Sb[ks] = (u32x4){cvt_pk_bf16(Sc[2 * ks][0], Sc[2 * ks][1]), cvt_pk_bf16(Sc[2 * ks][2], Sc[2 * ks][3]), cvt_pk_bf16(Sc[2 * ks + 1][0], Sc[2 * ks + 1][1]), cvt_pk_bf16(Sc[2 * ks + 1][2], Sc[2 * ks + 1][3])};
                __syncthreads();
            }
        }
    }
}
__device__ __forceinline__ void phase_gdn_out(KA a, int l, LAS unsigned char* lds, int bid, int G, bool st = true) {
    const int tid = TIDX(), wave = tid >> 6, lane = tid & 63, fr = lane & 15, fq = lane >> 4;
    unsigned char* ws = a->ws; bf16_t* P = (bf16_t*)(ws + WS_P);
    const bf16_t* QN = (const bf16_t*)(ws + WS_QN); const bf16_t* KN = (const bf16_t*)(ws + WS_KN); const bf16_t* UT = (const bf16_t*)(ws + WS_UT); const float* GC = (const float*)(ws + WS_GC);
    LAS float* oL = (LAS float*)lds;
    const int c_lo = (l == DEPTH - 1) ? 4 : 0, ncu = 36 - c_lo;
    const int grp = wave >> 2, dir = (wave >> 1) & 1, ih = wave & 1;
    for (int up = bid; up < NB * ncu * 2; up += G) {
        const int u = 2 * up + grp;
        const int h = u & 3, c = c_lo + (u >> 2) % ncu, b = (u >> 2) / ncu, row0 = gdn_row0(b, c);
        const size_t gu = (size_t)((b * 36 + c) * 4 + h), gu2 = gu * 2 + dir;
        const bf16_t* SOLD = (const bf16_t*)(ws + (dir ? WS_SOLD1 : WS_SOLD0)) + gu * 4096;
        const float* gcp = GC + gu2 * 64;
        bf16x8 qf[2][2], kf[4][2], sfr[4][2]; u32x4 vfr[4][2]; f32x4 gj[4], gr[2]; float gi[2];
#pragma unroll
        for (int ti = 0; ti < 2; ++ti) { const int ib = 16 * (2 * ih + ti);
#pragma unroll
            for (int ks = 0; ks < 2; ++ks) qf[ti][ks] = *(const bf16x8*)(QN + gu * 4096 + (size_t)(ib + fr) * 64 + ks * 32 + fq * 8);
            gi[ti] = gcp[ib + fr]; gr[ti] = *(const f32x4*)(gcp + ib + 4 * fq); }
#pragma unroll
        for (int jt = 0; jt < 4; ++jt) {
#pragma unroll
            for (int ks = 0; ks < 2; ++ks) kf[jt][ks] = *(const bf16x8*)(KN + gu * 4096 + (size_t)(16 * jt + fr) * 64 + ks * 32 + fq * 8);
            gj[jt] = *(const f32x4*)(gcp + 16 * jt + 4 * fq); }
#pragma unroll
        for (int nt = 0; nt < 4; ++nt)
#pragma unroll
            for (int t = 0; t < 2; ++t) { const bf16_t* vp = UT + gu2 * 4096 + (size_t)(16 * nt + fr) * 64 + 32 * t + 4 * fq; const u32x2 lo = *(const u32x2*)vp, hi2 = *(const u32x2*)(vp + 16);
                vfr[nt][t] = (u32x4){lo.x, lo.y, hi2.x, hi2.y}; sfr[nt][t] = *(const bf16x8*)(SOLD + (size_t)(16 * nt + fr) * 64 + t * 32 + fq * 8); }
        const int ii = (tid >> 2) & 63, g4 = tid & 3;
        bf16_t* zp = P + (size_t)(row0 + ii) * PW + C_GZ + h * 64 + 16 * g4; const u32x4 zw0 = *(const u32x4*)zp, zw1 = *(const u32x4*)(zp + 8);
        u32x4 pf[2][2];
#pragma unroll
        for (int ti = 0; ti < 2; ++ti) { const int i = 16 * (2 * ih + ti) + fr;
#pragma unroll
            for (int t = 0; t < 2; ++t) { f32x4 s2[2];
#pragma unroll
                for (int hh = 0; hh < 2; ++hh) { const int jt = 2 * t + hh; f32x4 acc = (f32x4){0.f, 0.f, 0.f, 0.f};
#pragma unroll
                    for (int ks = 0; ks < 2; ++ks) acc = __builtin_amdgcn_mfma_f32_16x16x32_bf16(kf[jt][ks], qf[ti][ks], acc, 0, 0, 0);
#pragma unroll
                    for (int r = 0; r < 4; ++r) { const int j = 16 * jt + 4 * fq + r; const bool valid = dir ? (j >= i) : (j <= i); acc[r] = valid ? acc[r] * __expf(gi[ti] - gj[jt][r]) : 0.f; }
                    s2[hh] = acc; }
                pf[ti][t] = (u32x4){cvt_pk_bf16(s2[0][0], s2[0][1]), cvt_pk_bf16(s2[0][2], s2[0][3]), cvt_pk_bf16(s2[1][0], s2[1][1]), cvt_pk_bf16(s2[1][2], s2[1][3])}; } }
        __syncthreads();
#pragma unroll
        for (int ti = 0; ti < 2; ++ti) { float er[4];
#pragma unroll
            for (int r = 0; r < 4; ++r) er[r] = __expf(gr[ti][r]);
#pragma unroll
            for (int nt = 0; nt < 4; ++nt) { f32x4 o1 = (f32x4){0.f, 0.f, 0.f, 0.f}, o2 = o1;
#pragma unroll
                for (int t = 0; t < 2; ++t) o1 = __builtin_amdgcn_mfma_f32_16x16x32_bf16(__builtin_bit_cast(bf16x8, pf[ti][t]), __builtin_bit_cast(bf16x8, vfr[nt][t]), o1, 0, 0, 0);
#pragma unroll
                for (int ks = 0; ks < 2; ++ks) o2 = __builtin_amdgcn_mfma_f32_16x16x32_bf16(qf[ti][ks], sfr[nt][ks], o2, 0, 0, 0);
#pragma unroll
                for (int r = 0; r < 4; ++r) oL[((grp * 2 + dir) * 64 + 16 * (2 * ih + ti) + 4 * fq + r) * 68 + 16 * nt + fr] = o1[r] + o2[r] * er[r]; } }
        __syncthreads();
        { const LAS float* p0 = oL + ((grp * 2) * 64 + ii) * 68 + 16 * g4; const LAS float* p1 = p0 + 64 * 68;
          float o16[16]; float ss = 0.f;
#pragma unroll
          for (int q = 0; q < 4; ++q) { const f32x4 a0 = *(const LAS f32x4*)(p0 + 4 * q), b0 = *(const LAS f32x4*)(p1 + 4 * q);
#pragma unroll
              for (int j = 0; j < 4; ++j) { o16[4 * q + j] = a0[j] + b0[j]; ss += o16[4 * q + j] * o16[4 * q + j]; } }
          ss += __shfl_xor(ss, 1); ss += __shfl_xor(ss, 2);
          const float rs = rsqrtf(ss * (1.f / 64.f) + EPS);
          float z16[16]; unpack8(zw0, z16); unpack8(zw1, z16 + 8);
          const float* ng = a->gdn_norm_g + l * 64 + 16 * g4;
          float y[16];
#pragma unroll
          for (int q = 0; q < 4; ++q) { const f32x4 g0 = *(const f32x4*)(ng + 4 * q);
#pragma unroll
              for (int j = 0; j < 4; ++j) y[4 * q + j] = o16[4 * q + j] * rs * g0[j] * silu_f(z16[4 * q + j]); }
          if (st) { *(u32x4*)zp = pack8(y); *(u32x4*)(zp + 8) = pack8(y + 8); } }
    }
}

constexpr size_t WS_SGW = 2 * MiB + 256 * 1024;
__device__ __forceinline__ void phase_sg(KA a, int l, LAS unsigned char* lds, int bid, int G, bool st = true) {
    const int tid = TIDX(), wave = tid >> 6, lane = tid & 63, fr = lane & 15, fq = lane >> 4;
    bf16_t* P = (bf16_t*)(a->ws + WS_P); const bf16_t* Wb = (const bf16_t*)(a->ws + WS_SGW) + (size_t)l * 4 * 128 * 128;
    LAS unsigned char* vT = lds;
    LAS float* red = (LAS float*)(lds + 256 * TS);
    const int nch = (l == DEPTH - 1) ? 16 : 18;
    for (int it = G - 1 - bid; it < NB * nch; it += G) {
        const int b = it / nch, c = it % nch, base = c < 16 ? b * TL + c * 128 : RL + b * TC + (c - 16) * 128;
        __syncthreads();
        float v0[32], v1[32];
        { const bf16_t* r0 = P + (size_t)(base + 2 * lane) * PW + C_SV + 32 * wave;
#pragma unroll
          for (int k = 0; k < 4; ++k) { unpack8(*(const u32x4*)(r0 + 8 * k), v0 + 8 * k); unpack8(*(const u32x4*)(r0 + PW + 8 * k), v1 + 8 * k); }
          float s0 = 0.f, q0 = 0.f, s1 = 0.f, q1 = 0.f;
#pragma unroll
          for (int j = 0; j < 32; ++j) { v0[j] = gelu_f(v0[j]); v1[j] = gelu_f(v1[j]); s0 += v0[j]; q0 += v0[j] * v0[j]; s1 += v1[j]; q1 += v1[j] * v1[j]; }
          *(LAS f32x4*)(red + (wave * 64 + lane) * 4) = (f32x4){s0, q0, s1, q1}; }
        __syncthreads();
        { float s0 = 0.f, q0 = 0.f, s1 = 0.f, q1 = 0.f;
#pragma unroll
          for (int w = 0; w < 8; ++w) { const f32x4 t = *(const LAS f32x4*)(red + (w * 64 + lane) * 4); s0 += t[0]; q0 += t[1]; s1 += t[2]; q1 += t[3]; }
          const float m0 = s0 * (1.f / 256.f), m1 = s1 * (1.f / 256.f);
          const float r0 = rsqrtf(fmaxf(q0 * (1.f / 256.f) - m0 * m0, 0.f) + EPS), r1 = rsqrtf(fmaxf(q1 * (1.f / 256.f) - m1 * m1, 0.f) + EPS);
#pragma unroll
          for (int j = 0; j < 32; ++j) *(LAS unsigned*)(vT + (32 * wave + j) * TS + lane * 4) = cvt_pk_bf16((v0[j] - m0) * r0, (v1[j] - m1) * r1); }
        __syncthreads();
        const int h = wave >> 1, ih = wave & 1; const bf16_t* Wh = Wb + (size_t)h * 128 * 128; const float* bs = a->sg_b + ((size_t)l * 4 + h) * 128;
#pragma unroll 2
        for (int itl = 0; itl < 4; ++itl) { const int i = 64 * ih + 16 * itl + fr;
            bf16x8 bfr[4];
#pragma unroll
            for (int ks = 0; ks < 4; ++ks) bfr[ks] = *(const bf16x8*)(Wh + (size_t)i * 128 + ks * 32 + fq * 8);
            const float bias = bs[i]; bf16_t* rowp = P + (size_t)(base + i) * PW + h * 64 + 4 * fq;
#pragma unroll
            for (int dt = 0; dt < 4; ++dt) { f32x4 acc = (f32x4){0.f, 0.f, 0.f, 0.f};
#pragma unroll
                for (int ks = 0; ks < 4; ++ks) { const bf16x8 afr = *(const LAS bf16x8*)(vT + (h * 64 + 16 * dt + fr) * TS + (ks * 32 + fq * 8) * 2); acc = __builtin_amdgcn_mfma_f32_16x16x32_bf16(afr, bfr[ks], acc, 0, 0, 0); }
                const u32x2 uw = *(const u32x2*)(rowp + C_SU + 16 * dt), zw = *(const u32x2*)(rowp + C_SZ + 16 * dt);
                const float u4[4] = {bf2f(uw.x & 0xffffu), bf2f(uw.x >> 16), bf2f(uw.y & 0xffffu), bf2f(uw.y >> 16)}, z4[4] = {bf2f(zw.x & 0xffffu), bf2f(zw.x >> 16), bf2f(zw.y & 0xffffu), bf2f(zw.y >> 16)};
                float y[4];
#pragma unroll
                for (int r = 0; r < 4; ++r) y[r] = gelu_f(u4[r]) * (acc[r] + bias) * silu_f(z4[r]);
                u32x2 o; o.x = cvt_pk_bf16(y[0], y[1]); o.y = cvt_pk_bf16(y[2], y[3]); if (st) *(u32x2*)(rowp + C_SU + 16 * dt) = o; } }
    }
}

__device__ __forceinline__ void phase_chain_and_ret(KA a, int l, LAS unsigned char* lds, int bid, int G) {
    const int N = NB * ((l == DEPTH - 1) ? 16 : 18) * 4;
    if (G >= 256) { const int n_tail = 3 * 128;
        if (bid < 128) { phase_gdn_chain(a, l, lds, bid, 128); phase_ret_out(a, l, lds, bid, 128, N - n_tail, N); }
        else phase_ret_out(a, l, lds, bid - 128, G - 128, 0, N - n_tail); }
    else { phase_gdn_chain(a, l, lds, bid, G); phase_ret_out(a, l, lds, bid, G, 0, N); }
}

#define XB_TMO      128
#define XB_XCNT(j)  (256  + 64 * (j))
#define XB_XSUB(j)  (1280 + 64 * (j))
#define XB_XGEN(j)  (2304 + 64 * (j))
#define XB_TOP      3328
#define XB_TOPGEN   3392
#define XCD_BAR_WORDS 3456
#define XB_SPIN_CAP (1u << 18)
__device__ __forceinline__ unsigned xb_ld(unsigned* p)              { return __hip_atomic_load(p, __ATOMIC_RELAXED, __HIP_MEMORY_SCOPE_AGENT); }
__device__ __forceinline__ unsigned xb_add(unsigned* p, unsigned v) { return __hip_atomic_fetch_add(p, v, __ATOMIC_RELAXED, __HIP_MEMORY_SCOPE_AGENT); }
__device__ __forceinline__ unsigned xb_xcc_id() { return (unsigned)__builtin_amdgcn_s_getreg((3 << 11) | 20) & 0xFu; }
#define XB_SPIN(cond, bar) do { unsigned _sp = 0; while (cond) { __builtin_amdgcn_s_sleep(1); \
    if ((++_sp & 255u) == 0u) { if (xb_ld(&(bar)[XB_TMO])) break; if (_sp > XB_SPIN_CAP) { atomicAdd(&(bar)[XB_TMO], 1u); break; } } } } while (0)
struct XcdBarrier { unsigned* bar; unsigned x; volatile LAS unsigned* st; };
__device__ __forceinline__ XcdBarrier xcd_barrier_post(unsigned* bar, volatile LAS unsigned* st) {
    XcdBarrier b; b.bar = bar; b.x = xb_xcc_id(); b.st = st;
    if (threadIdx.x == 0) (void)xb_add(&bar[XB_XCNT(b.x)], 1u);
    return b;
}
__device__ __forceinline__ void xcd_barrier_complete(unsigned* bar, unsigned x, unsigned& nloc, unsigned& nx) {
    const unsigned G = gridDim.x * gridDim.y * gridDim.z;
    unsigned sum, cnt, mine, sp = 0u;
    for (;;) {
        sum = 0u; cnt = 0u; mine = 0u;
#pragma unroll
        for (unsigned j = 0; j < 16; ++j) { const unsigned c = xb_ld(&bar[XB_XCNT(j)]); sum += c; cnt += (c > 0u) ? 1u : 0u; mine = (j == x) ? c : mine; }
        if (sum == G) break;
        __builtin_amdgcn_s_sleep(1);
        if ((++sp & 255u) == 0u) { if (xb_ld(&bar[XB_TMO])) break; if (sp > XB_SPIN_CAP) { atomicAdd(&bar[XB_TMO], 1u); break; } }
    }
    nloc = mine > 0u ? mine : 1u; nx = cnt > 0u ? cnt : 1u;
}
__device__ __forceinline__ void xcd_barrier(const XcdBarrier& b) {
    asm volatile("s_waitcnt vmcnt(0)" ::: "memory");
    __syncthreads();
    if (threadIdx.x == 0) {
        unsigned* bar = b.bar;
        __builtin_amdgcn_s_waitcnt(0);
        unsigned nloc = b.st[0], nx = b.st[1];
        if (nloc == 0u) { xcd_barrier_complete(bar, b.x, nloc, nx); b.st[0] = nloc; b.st[1] = nx; }
        const unsigned old = xb_add(&bar[XB_XSUB(b.x)], 1u);
        const unsigned gen = old / nloc;
        if (old + 1u == (gen + 1u) * nloc) {
            __builtin_amdgcn_fence(__ATOMIC_RELEASE, "agent");
            asm volatile("s_waitcnt vmcnt(0)" ::: "memory");
            const unsigned og = xb_add(&bar[XB_TOP], 1u);
            const unsigned tg = og / nx;
            if (og + 1u == (tg + 1u) * nx) xb_add(&bar[XB_TOPGEN], 1u);
            else XB_SPIN(xb_ld(&bar[XB_TOPGEN]) == tg, bar);
            __builtin_amdgcn_fence(__ATOMIC_ACQUIRE, "agent");
            xb_add(&bar[XB_XGEN(b.x)], 1u);
            asm volatile("s_waitcnt vmcnt(0)" ::: "memory");
        } else {
            XB_SPIN(xb_ld(&bar[XB_XGEN(b.x)]) == gen, bar);
            __builtin_amdgcn_fence(__ATOMIC_ACQUIRE, "agent");
            asm volatile("s_waitcnt vmcnt(0)" ::: "memory");
        }
    }
    __syncthreads();
}

constexpr int STEPS_PER_LAYER = 6, N_STEPS = 1 + DEPTH * STEPS_PER_LAYER + 1;

__global__ void __launch_bounds__(512, 2) fwd_megakernel(Args a) {
    extern __shared__ __attribute__((aligned(16))) unsigned char lds_raw[];
    LAS unsigned char* lds = (LAS unsigned char*)lds_raw;
    cg::grid_group grid = cg::this_grid();
    const int bid = blockIdx.x, G = gridDim.x;
    const int st_lo = a.st_lo, st_hi = a.st_hi, coop = a.coop;
    KA ka = (KA)__builtin_amdgcn_kernarg_segment_ptr();
#if PROBE_K >= 0
    unsigned long long* ts = (unsigned long long*)(a.ws + WS_CTL + 15360);
#define STAMP(i) do { if (bid == 0 && threadIdx.x == 0) ts[i] = __builtin_amdgcn_s_memrealtime(); } while (0)
#else
#define STAMP(i) do { } while (0)
#endif
    volatile LAS unsigned* xst = (volatile LAS unsigned*)(lds + LDS_BYTES - 64);
    if (threadIdx.x < 2) xst[threadIdx.x] = 0u;
    __syncthreads();
    const XcdBarrier xb = xcd_barrier_post((unsigned*)(a.ws + WS_CTL), xst);
#define STEP(idx, call) do { const int _i = (idx); if (st_lo <= _i && _i < st_hi) { STAMP(_i); call; if (_i + 1 < st_hi) { if (coop) { if (_i == 0) grid.sync(); else xcd_barrier(xb); } else __syncthreads(); } } } while (0)
    STEP(0, phase_prologue(ka, lds, bid, G));
#define NOST (ka->pad == 777)
#if PROBE_R == 26
#define PROBE_A(l, s0) STEP(s0 + 0, phase_norm(ka, l, bid, G, NOST));
#else
#define PROBE_A(l, s0)
#endif
#if PROBE_R == 21
#define PROBE_C(l) phase_ret_kv(ka, l, lds, bid, G),
#elif PROBE_R == 22
#define PROBE_C(l) phase_sg(ka, l, lds, bid, G, NOST),
#elif PROBE_R == 23
#define PROBE_C(l) phase_sc(ka, l, bid, G, NOST),
#else
#define PROBE_C(l)
#endif
#if PROBE_R == 24
#define PROBE_E(l, s0) STEP(s0 + 4, phase_gdn_out(ka, l, lds, bid, G, NOST));
#elif PROBE_R == 25
#define PROBE_E(l, s0) STEP(s0 + 4, phase_ret_out(ka, l, lds, bid, G, 0, NB * ((l == DEPTH - 1) ? 16 : 18) * 4, NOST));
#else
#define PROBE_E(l, s0)
#endif
#define LAYER(l) do { constexpr int s0 = 1 + (l) * STEPS_PER_LAYER; \
        PROBE_A(l, s0) STEP(s0 + 0, phase_norm(ka, l, bid, G)); \
        STEP(s0 + 1, phase_gemm(ka, l, false, lds, bid, G)); \
        STEP(s0 + 2, (phase_gdn_prep2(ka, l, lds, bid, G), phase_ret_kv(ka, l, lds, bid, G), PROBE_C(l) phase_sg(ka, l, lds, bid, G), phase_sc(ka, l, bid, G))); \
        STEP(s0 + 3, phase_chain_and_ret(ka, l, lds, bid, G)); \
        PROBE_E(l, s0) \
        STEP(s0 + 4, phase_gdn_out(ka, l, lds, bid, G)); \
        STEP(s0 + 5, phase_gemm(ka, l, true, lds, bid, G)); } while (0)
    LAYER(0); LAYER(1); LAYER(2); LAYER(3);
    STEP(N_STEPS - 1, phase_norm(ka, DEPTH, bid, G));
#if PROBE_K >= 0
    STAMP(N_STEPS);
    __syncthreads();
    if (bid == 0 && threadIdx.x == 0) { unsigned long long tot = 0;
        for (int i = 0; i < N_STEPS; ++i) { const int cls = i == 0 ? 0 : (i == N_STEPS - 1 ? 1 : 1 + (i - 1) % STEPS_PER_LAYER); if (cls == PROBE_K || PROBE_K == 99) tot += ts[i + 1] - ts[i]; }
        a.out[0] = (float)tot * 0.01f; }
#endif
#undef STEP
}

extern "C" void kernel_launch(void* const* d_in, const int* in_sizes, int n_in, void* d_out, int out_size, void* d_ws, size_t ws_size, hipStream_t stream) {
    static int grid = 0;
    if (grid == 0) {
        int dev = 0, cus = 0, per_cu = 0;
        hipGetDevice(&dev); hipDeviceGetAttribute(&cus, hipDeviceAttributeMultiprocessorCount, dev);
        if (hipFuncSetAttribute((const void*)fwd_megakernel, hipFuncAttributeMaxDynamicSharedMemorySize, LDS_BYTES) != hipSuccess) { fprintf(stderr, "hipFuncSetAttribute failed\n"); grid = -1; return; }
        if (hipOccupancyMaxActiveBlocksPerMultiprocessor(&per_cu, (const void*)fwd_megakernel, 512, LDS_BYTES) != hipSuccess || per_cu < 1) { fprintf(stderr, "occupancy query failed (%d)\n", per_cu); per_cu = 1; }
        (void)hipGetLastError();
        grid = cus * per_cu;
        if (ws_size < WS_END2) { fprintf(stderr, "workspace too small: %zu < %zu\n", ws_size, (size_t)WS_END); grid = -1; return; }
    }
    if (grid < 0) return;
    Args a{};
    const float** ap = (const float**)&a;
    for (int i = 0; i < 18; ++i) ap[i] = (const float*)d_in[i];
    a.out = (float*)d_out; a.ws = (unsigned char*)d_ws;
    hipMemsetAsync((char*)d_ws + WS_CTL, 0, 16384, stream);
#if MK_MULTI
    for (int st = 0; st < N_STEPS; ++st) { a.st_lo = st; a.st_hi = st + 1; a.coop = 0; hipLaunchKernelGGL(fwd_megakernel, dim3(grid), dim3(512), LDS_BYTES, stream, a); }
#else
    a.st_lo = 0; a.st_hi = N_STEPS; a.coop = 1;
    void* args[] = {&a};
    hipError_t e = hipLaunchCooperativeKernel((const void*)fwd_megakernel, dim3(grid), dim3(512), args, LDS_BYTES, stream);
    if (e != hipSuccess) fprintf(stderr, "cooperative launch failed: %s (grid %d)\n", hipGetErrorString(e), grid);
#endif
}
```
